# Optimizing an MI355X kernel written in HIP

```python
import math
import jax, jax.numpy as jnp
from jax import lax
import numpy as np

D_MODEL = 1024
BATCH = 16
SEQ = 2048
DEPTH = 4

D_MIX = D_MODEL
D_SSM = D_MIX // 2
D_ATT = D_MIX - D_SSM
SSM_GROUP = 16
SSM_GROUPS = D_SSM // SSM_GROUP
SSM_STATE = 64
DIFF_HEAD = 64
N_DIFF_HEADS = D_ATT // (2 * DIFF_HEAD)
DIFF_VDIM = 2 * DIFF_HEAD
ROT_DIM = DIFF_HEAD // 4
ROPE_THETA = 500000.0
Q_BLOCK = 128
D_FF = -(-8 * D_MODEL // (3 * 256)) * 256
IN_COLS = D_SSM + 3 * D_ATT
DEEPNORM_ALPHA = (2 * DEPTH) ** 0.25
DEEPNORM_BETA = (8 * DEPTH) ** -0.25
LN_EPS = 1e-5
RMS_EPS = 1e-5

kernel_name = "hybrid_s5_diffattn_deepnorm_adaln"


def layer_norm(x, g, b):
    x32 = x.astype(jnp.float32)
    mu = jnp.mean(x32, axis=-1, keepdims=True)
    xc = x32 - mu
    var = jnp.mean(xc * xc, axis=-1, keepdims=True)
    y = xc * lax.rsqrt(var + LN_EPS) * g.astype(jnp.float32) + b.astype(jnp.float32)
    return y.astype(x.dtype)


def apply_rotary(t, cos, sin):
    t_rot, t_pass = t[..., :ROT_DIM], t[..., ROT_DIM:]
    t1, t2 = t_rot[..., :ROT_DIM // 2], t_rot[..., ROT_DIM // 2:]
    rotated = jnp.concatenate([t1 * cos - t2 * sin, t2 * cos + t1 * sin], axis=-1)
    return jnp.concatenate([rotated.astype(t.dtype), t_pass], axis=-1)


def s5_mixer(u, a_re, a_im, log_step, b_re, b_im, c_re, c_im, d_skip, glu_w, glu_b):
    bsz, seqlen = u.shape[0], u.shape[1]
    f32 = jnp.float32
    u32 = u.astype(f32).reshape(bsz, seqlen, SSM_GROUPS, SSM_GROUP)
    delta = jnp.exp(log_step.astype(f32))[:, None]
    lam_re = jnp.minimum(a_re.astype(f32), -1e-4)
    lam_im = a_im.astype(f32)
    mag = jnp.exp(lam_re * delta)
    ang = lam_im * delta
    lb_re, lb_im = mag * jnp.cos(ang), mag * jnp.sin(ang)
    den = lam_re * lam_re + lam_im * lam_im
    n_re, n_im = lb_re - 1.0, lb_im
    k_re = (n_re * lam_re + n_im * lam_im) / den
    k_im = (n_im * lam_re - n_re * lam_im) / den
    b_re32, b_im32 = b_re.astype(f32), b_im.astype(f32)
    bb_re = k_re[..., None] * b_re32 - k_im[..., None] * b_im32
    bb_im = k_re[..., None] * b_im32 + k_im[..., None] * b_re32
    bu_re = jnp.einsum('blgc,gpc->blgp', u32, bb_re)
    bu_im = jnp.einsum('blgc,gpc->blgp', u32, bb_im)
    a_t_re = jnp.broadcast_to(lb_re, (1, seqlen, SSM_GROUPS, SSM_STATE))
    a_t_im = jnp.broadcast_to(lb_im, (1, seqlen, SSM_GROUPS, SSM_STATE))

    def combine(left, right):
        a1r, a1i, b1r, b1i = left
        a2r, a2i, b2r, b2i = right
        ar = a2r * a1r - a2i * a1i
        ai = a2r * a1i + a2i * a1r
        br = a2r * b1r - a2i * b1i + b2r
        bi = a2r * b1i + a2i * b1r + b2i
        return (ar, ai, br, bi)

    _, _, st_re, st_im = lax.associative_scan(combine, (a_t_re, a_t_im, bu_re, bu_im), axis=1)
    y = (jnp.einsum('blgp,gcp->blgc', st_re, c_re.astype(f32))
         - jnp.einsum('blgp,gcp->blgc', st_im, c_im.astype(f32))
         + d_skip.astype(f32) * u32)
    y = jax.nn.gelu(y).reshape(bsz, seqlen, D_SSM)
    y = y * jax.nn.sigmoid(y @ glu_w.astype(f32) + glu_b.astype(f32))
    return y.astype(u.dtype)


def diff_attention(q, k, v, lam, lam_init, subln_w):
    bsz, seqlen = q.shape[0], q.shape[1]
    f32 = jnp.float32
    n_blocks = seqlen // Q_BLOCK
    q = q * (DIFF_HEAD ** -0.5)
    qb = q.reshape(bsz, n_blocks, Q_BLOCK, N_DIFF_HEADS, 2, DIFF_HEAD).transpose(1, 0, 2, 3, 4, 5)
    v32 = v.astype(f32)
    key_idx = jnp.arange(seqlen)
    gain = subln_w.astype(f32) * (1.0 - lam_init)

    def block(args):
        q_blk, i = args
        s = jnp.einsum('bqhmd,bkhmd->bhmqk', q_blk, k).astype(f32)
        q_idx = i * Q_BLOCK + jnp.arange(Q_BLOCK)
        mask = key_idx[None, :] <= q_idx[:, None]
        s = jnp.where(mask, s, -jnp.inf)
        p = jax.nn.softmax(s, axis=-1)
        w = p[:, :, 0] - lam * p[:, :, 1]
        o = jnp.einsum('bhqk,bkhe->bqhe', w, v32)
        o = o * lax.rsqrt(jnp.mean(o * o, axis=-1, keepdims=True) + RMS_EPS) * gain
        return o

    out = lax.map(block, (qb, jnp.arange(n_blocks)))
    return out.transpose(1, 0, 2, 3, 4).reshape(bsz, seqlen, N_DIFF_HEADS * DIFF_VDIM)


def setup_inputs(seed: int = 0) -> dict:
    key = jax.random.key(seed)
    ks = jax.random.split(key, 32)
    f32 = jnp.float32

    def nrm(k, shape, scale):
        return jax.random.normal(k, shape, f32) * scale

    nl, G, P, C = DEPTH, SSM_GROUPS, SSM_STATE, SSM_GROUP
    x = nrm(ks[0], (BATCH, SEQ, D_MODEL), 1.0)
    c = nrm(ks[1], (BATCH, D_MODEL), 1.0)
    offset = jax.random.randint(ks[2], (BATCH, 1), 0, 4096, dtype=jnp.int32)
    positions = offset + jnp.arange(SEQ, dtype=jnp.int32)[None, :]
    mod_w = nrm(ks[3], (nl, D_MODEL, 6 * D_MODEL), 0.1 * D_MODEL ** -0.5)
    mod_b = nrm(ks[4], (nl, 6 * D_MODEL), 0.01)
    w_in = nrm(ks[5], (nl, D_MODEL, IN_COLS), D_MODEL ** -0.5)
    n_idx = jnp.arange(P, dtype=f32)
    ssm_a_re = -0.5 + nrm(ks[6], (nl, G, P), 0.01)
    ssm_a_im = math.pi * n_idx + nrm(ks[7], (nl, G, P), 0.01)
    ssm_log_step = jax.random.uniform(ks[8], (nl, G), f32, math.log(1e-3), math.log(1e-1))
    ssm_b_re = nrm(ks[9], (nl, G, P, C), (2 * C) ** -0.5)
    ssm_b_im = nrm(ks[10], (nl, G, P, C), (2 * C) ** -0.5)
    ssm_c_re = nrm(ks[11], (nl, G, C, P), P ** -0.5)
    ssm_c_im = nrm(ks[12], (nl, G, C, P), P ** -0.5)
    ssm_d = nrm(ks[13], (nl, G, C), 1.0)
    glu_w = nrm(ks[14], (nl, D_SSM, D_SSM), D_SSM ** -0.5)
    glu_b = nrm(ks[15], (nl, D_SSM), 0.01)
    lam_q1 = nrm(ks[16], (nl, DIFF_HEAD), 0.1)
    lam_k1 = nrm(ks[17], (nl, DIFF_HEAD), 0.1)
    lam_q2 = nrm(ks[18], (nl, DIFF_HEAD), 0.1)
    lam_k2 = nrm(ks[19], (nl, DIFF_HEAD), 0.1)
    subln_w = 1.0 + nrm(ks[20], (nl, DIFF_VDIM), 0.02)
    w_out = nrm(ks[21], (nl, D_MIX, D_MODEL), DEEPNORM_BETA * D_MIX ** -0.5)
    ln1_g = 1.0 + nrm(ks[22], (nl, D_MODEL), 0.02)
    ln1_b = nrm(ks[23], (nl, D_MODEL), 0.01)
    ffn_w_gate = nrm(ks[24], (nl, D_MODEL, D_FF), D_MODEL ** -0.5)
    ffn_w_up = nrm(ks[25], (nl, D_MODEL, D_FF), D_MODEL ** -0.5)
    ffn_w_down = nrm(ks[26], (nl, D_FF, D_MODEL), DEEPNORM_BETA * D_FF ** -0.5)
    ln2_g = 1.0 + nrm(ks[27], (nl, D_MODEL), 0.02)
    ln2_b = nrm(ks[28], (nl, D_MODEL), 0.01)
    return {"x": x, "c": c, "positions": positions,
            "mod_w": mod_w, "mod_b": mod_b, "w_in": w_in,
            "ssm_a_re": ssm_a_re, "ssm_a_im": ssm_a_im, "ssm_log_step": ssm_log_step,
            "ssm_b_re": ssm_b_re, "ssm_b_im": ssm_b_im, "ssm_c_re": ssm_c_re, "ssm_c_im": ssm_c_im,
            "ssm_d": ssm_d, "glu_w": glu_w, "glu_b": glu_b,
            "lam_q1": lam_q1, "lam_k1": lam_k1, "lam_q2": lam_q2, "lam_k2": lam_k2,
            "subln_w": subln_w, "w_out": w_out, "ln1_g": ln1_g, "ln1_b": ln1_b,
            "ffn_w_gate": ffn_w_gate, "ffn_w_up": ffn_w_up, "ffn_w_down": ffn_w_down,
            "ln2_g": ln2_g, "ln2_b": ln2_b}


def reference(x, c, positions, mod_w, mod_b, w_in, ssm_a_re, ssm_a_im, ssm_log_step,
              ssm_b_re, ssm_b_im, ssm_c_re, ssm_c_im, ssm_d, glu_w, glu_b,
              lam_q1, lam_k1, lam_q2, lam_k2, subln_w, w_out, ln1_g, ln1_b,
              ffn_w_gate, ffn_w_up, ffn_w_down, ln2_g, ln2_b):
    bsz, seqlen = x.shape[0], x.shape[1]
    f32 = jnp.float32
    cond = jax.nn.silu(c)
    freqs = ROPE_THETA ** (-jnp.arange(0, ROT_DIM, 2, dtype=f32) / ROT_DIM)
    angles = positions.astype(f32)[..., None] * freqs
    cos = jnp.cos(angles)[:, :, None, None, :]
    sin = jnp.sin(angles)[:, :, None, None, :]

    for l in range(DEPTH):
        lam_init = 0.8 - 0.6 * math.exp(-0.3 * l)
        mod = cond @ mod_w[l] + mod_b[l]
        shift1, scale1, gate1, shift2, scale2, gate2 = [m[:, None, :] for m in jnp.split(mod, 6, axis=-1)]

        h = x * (1.0 + scale1) + shift1
        proj = h @ w_in[l]
        u, q, k, v = jnp.split(proj, [D_SSM, D_SSM + D_ATT, D_SSM + 2 * D_ATT], axis=-1)
        ssm_out = s5_mixer(u, ssm_a_re[l], ssm_a_im[l], ssm_log_step[l], ssm_b_re[l], ssm_b_im[l],
                           ssm_c_re[l], ssm_c_im[l], ssm_d[l], glu_w[l], glu_b[l])
        q = apply_rotary(q.reshape(bsz, seqlen, N_DIFF_HEADS, 2, DIFF_HEAD), cos, sin)
        k = apply_rotary(k.reshape(bsz, seqlen, N_DIFF_HEADS, 2, DIFF_HEAD), cos, sin)
        v = v.reshape(bsz, seqlen, N_DIFF_HEADS, DIFF_VDIM)
        lam = (jnp.exp(jnp.sum(lam_q1[l].astype(f32) * lam_k1[l].astype(f32)))
               - jnp.exp(jnp.sum(lam_q2[l].astype(f32) * lam_k2[l].astype(f32))) + lam_init)
        att_out = diff_attention(q, k, v, lam, lam_init, subln_w[l])
        mix = jnp.concatenate([ssm_out, att_out.astype(x.dtype)], axis=-1) @ w_out[l]
        x = layer_norm(DEEPNORM_ALPHA * x + (1.0 + gate1) * mix, ln1_g[l], ln1_b[l])

        h = x * (1.0 + scale2) + shift2
        ffn = (jax.nn.silu(h @ ffn_w_gate[l]) * (h @ ffn_w_up[l])) @ ffn_w_down[l]
        x = layer_norm(DEEPNORM_ALPHA * x + (1.0 + gate2) * ffn, ln2_g[l], ln2_b[l])
    return x
```

```cpp
#include <hip/hip_runtime.h>
#include <hip/hip_cooperative_groups.h>
#include <hip/hip_bf16.h>
#include <cstdio>
#include <cstdint>
#include <cmath>
namespace cg = cooperative_groups;

namespace pg8 {
#define PG8_LAS __attribute__((address_space(3)))
typedef unsigned short bf16_t;
typedef short bf16x8 __attribute__((ext_vector_type(8)));
typedef float f32x4 __attribute__((ext_vector_type(4)));
typedef unsigned u32x4 __attribute__((ext_vector_type(4)));
constexpr int BM = 256, BK = 64, HALF = 128, HTB = HALF * BK * 2, STAGE_BYTES = 8 * HTB, NXCD = 8, WGM = 8;

__host__ __device__ __forceinline__ int lds_byte(int r, int c) { const int st = (r >> 4) * 2 + (c >> 5), rr = r & 15, cc = c & 31, ob = rr * 64 + cc * 2; return st * 1024 + (ob ^ (((ob >> 9) & 1) << 5)); }
__host__ __device__ __forceinline__ void stage_rc(int b, int& R, int& C) { const int st = b / 1024, sb = b % 1024, swz = sb ^ (((sb >> 9) & 1) << 5); R = (st >> 1) * 16 + swz / 64; C = (st & 1) * 32 + (swz % 64) / 2; }
__host__ __device__ __forceinline__ int perm32(int rho) { const int n = rho >> 4, i = rho & 15; return 8 * (i >> 2) + 4 * n + (i & 3); }

struct Unit { int pm, pn; };
struct Gemm { const bf16_t* A; const bf16_t* Bt; int M, N, K, lda, ldb, pm_per_batch; size_t bstrideB; };

struct StaticOrder {
    int nM, nN, nwg, G, c;
    __host__ __device__ void init(int M, int N, int G_, int c_) { nM = M / BM; nN = N / BM; nwg = nM * nN; G = G_; c = c_; }
    __host__ __device__ bool next(int i, Unit& u) const {
        const long L = (long)i * G + c; if (L >= nwg) return false;
        int wgid = (int)L; { const int q = nwg / NXCD, r = nwg % NXCD, xcd = wgid % NXCD, off = wgid / NXCD; wgid = (xcd < r ? xcd * (q + 1) : r * (q + 1) + (xcd - r) * q) + off; }
        const int nig = WGM * nN, gid = wgid / nig, fm = gid * WGM, gsz = (nM - fm) < WGM ? (nM - fm) : WGM;
        u.pm = fm + ((wgid % nig) % gsz); u.pn = (wgid % nig) / gsz; return true;
    }
};

__device__ __forceinline__ unsigned cvt_pk_bf16(float lo, float hi) { unsigned r; asm volatile("v_cvt_pk_bf16_f32 %0, %1, %2" : "=v"(r) : "v"(lo), "v"(hi)); return r; }
__device__ __forceinline__ u32x4 pack8(const f32x4 v0, const f32x4 v1) { u32x4 w; w.x = cvt_pk_bf16(v0[0], v0[1]); w.y = cvt_pk_bf16(v0[2], v0[3]); w.z = cvt_pk_bf16(v1[0], v1[1]); w.w = cvt_pk_bf16(v1[2], v1[3]); return w; }
__device__ __forceinline__ float sigm(float x) { return __builtin_amdgcn_rcpf(1.0f + __expf(-x)); }


typedef _Float16 f16x8 __attribute__((ext_vector_type(8)));
template <class Epi, class Sched, bool F16 = false>
__device__ __forceinline__ void gemm_phase(PG8_LAS unsigned char* lds, const Gemm g, const Sched& S, const Epi& E, int tid) {
    asm volatile("" : "+v"(tid));
    const int wid = __builtin_amdgcn_readfirstlane(tid >> 6), lane = tid & 63, wr = wid >> 2, wc = wid & 3, fr = lane & 15, fq = lane >> 4;
    const int K = g.K, nt = K / BK;
    unsigned voffA[2], voffB[2];
#pragma unroll
    for (int i = 0; i < 2; ++i) { int R, C; stage_rc(tid * 16 + i * 8192, R, C); const int Rb = Epi::PERM ? ((R & ~31) + perm32(R & 31)) : R;
        voffA[i] = (unsigned)(R * g.lda + C) * 2u; voffB[i] = (unsigned)(Rb * g.ldb + C) * 2u; }
    const size_t kstep = (size_t)(BK * 2);
    const size_t hsA = (size_t)HALF * g.lda * 2, hsB = (size_t)HALF * g.ldb * 2;
    const size_t tsA = 2 * hsA, tsB = 2 * hsB;
    const unsigned ldsw = (unsigned)wid * 1024u;
    const int aoff = lds_byte(wr * 64 + fr, fq * 8), boff = lds_byte(wc * 32 + fr, fq * 8);
#define PG8_SA(b, h) (((b) * 2 + (h)) * HTB)
#define PG8_SB(b, h) ((4 + (b) * 2 + (h)) * HTB)
#define PG8_STAGE(bufoff, gbase, voff) do { _Pragma("unroll") for (int _i = 0; _i < 2; ++_i) \
        __builtin_amdgcn_global_load_lds((const unsigned*)((const char*)(gbase) + (voff)[_i]), (PG8_LAS unsigned*)(lds + (bufoff) + ldsw + _i * 8192), 16, 0, 0); } while (0)
#define PG8_LDA(dst, b, h) do { _Pragma("unroll") for (int m = 0; m < 4; ++m) _Pragma("unroll") for (int k = 0; k < 2; ++k) dst[m][k] = *(const PG8_LAS bf16x8*)(lds + PG8_SA(b, h) + aoff + m * 2048 + k * 1024); } while (0)
#define PG8_LDB(dst, b, h) do { _Pragma("unroll") for (int n = 0; n < 2; ++n) _Pragma("unroll") for (int k = 0; k < 2; ++k) dst[n][k] = *(const PG8_LAS bf16x8*)(lds + PG8_SB(b, h) + boff + n * 2048 + k * 1024); } while (0)
#define PG8_MMA(ai, bj, At, Bt) do { __builtin_amdgcn_s_setprio(1); _Pragma("unroll") for (int m = 0; m < 4; ++m) _Pragma("unroll") for (int n = 0; n < 2; ++n) _Pragma("unroll") for (int k = 0; k < 2; ++k) \
        { if constexpr (F16) acc[ai][bj][m][n] = __builtin_amdgcn_mfma_f32_16x16x32_f16(__builtin_bit_cast(f16x8, Bt[n][k]), __builtin_bit_cast(f16x8, At[m][k]), acc[ai][bj][m][n], 0, 0, 0); \
          else acc[ai][bj][m][n] = __builtin_amdgcn_mfma_f32_16x16x32_bf16(Bt[n][k], At[m][k], acc[ai][bj][m][n], 0, 0, 0); } __builtin_amdgcn_s_setprio(0); } while (0)
#define PG8_WAIT_V(n) asm volatile("s_waitcnt vmcnt(" #n ")" ::: "memory")
#define PG8_WAIT_L(n) asm volatile("s_waitcnt lgkmcnt(" #n ")" ::: "memory")
#define PG8_BAR __builtin_amdgcn_s_barrier()
#define PG8_SCHED __builtin_amdgcn_sched_barrier(0)
#define PG8_BASEA(u) ((const char*)g.A + (size_t)(u).pm * tsA)
#define PG8_BASEB(u) ((const char*)g.Bt + (size_t)((u).pm / g.pm_per_batch) * g.bstrideB * 2 + (size_t)(u).pn * tsB)
    Unit cur, nxt; int ui = 0;
    if (!S.next(0, cur)) return;
    f32x4 acc[2][2][4][2];
#pragma unroll
    for (int a = 0; a < 2; ++a)
#pragma unroll
        for (int b = 0; b < 2; ++b)
#pragma unroll
            for (int m = 0; m < 4; ++m)
#pragma unroll
                for (int n = 0; n < 2; ++n) acc[a][b][m][n] = (f32x4){0.f, 0.f, 0.f, 0.f};
    bf16x8 At[4][2], B0[2][2], B1[2][2];
    typename Epi::Pre pre;
    const char* cA = PG8_BASEA(cur); const char* cB = PG8_BASEB(cur);
    PG8_STAGE(PG8_SB(0, 0), cB, voffB); PG8_STAGE(PG8_SB(0, 1), cB + hsB, voffB); PG8_STAGE(PG8_SA(0, 0), cA, voffA); PG8_STAGE(PG8_SA(0, 1), cA + hsA, voffA);
    if (wr == 1) PG8_BAR;
    PG8_WAIT_V(2); PG8_BAR;
    PG8_STAGE(PG8_SB(1, 0), cB + kstep, voffB); PG8_STAGE(PG8_SA(1, 0), cA + kstep, voffA); PG8_STAGE(PG8_SB(1, 1), cB + hsB + kstep, voffB);
    PG8_WAIT_V(6); PG8_BAR;
    for (;;) {
        const bool has_next = S.next(ui + 1, nxt);
        const char* nA = has_next ? PG8_BASEA(nxt) : cA; const char* nB = has_next ? PG8_BASEB(nxt) : cB;
        E.prefetch(cur, wid, lds + STAGE_BYTES + 4096 + wid * 256);
        for (int t = 0; t < nt; t += 2) {
            const bool last = (t == nt - 2);
            const char* a1 = cA + (size_t)(t + 1) * kstep;
            const char* a2 = last ? nA : cA + (size_t)(t + 2) * kstep; const char* b2 = last ? nB : cB + (size_t)(t + 2) * kstep;
            const char* a3 = a2 + kstep; const char* b3 = b2 + kstep;
            PG8_LDB(B0, 0, 0); PG8_LDB(B1, 0, 1); PG8_SCHED; PG8_LDA(At, 0, 0); PG8_STAGE(PG8_SA(1, 1), a1 + hsA, voffA);
            PG8_WAIT_V(8); PG8_WAIT_L(0); PG8_BAR; PG8_MMA(0, 0, At, B0); PG8_MMA(0, 1, At, B1); PG8_BAR; PG8_SCHED;
            PG8_LDA(At, 0, 1); PG8_STAGE(PG8_SB(0, 0), b2, voffB); PG8_STAGE(PG8_SB(0, 1), b2 + hsB, voffB); PG8_STAGE(PG8_SA(0, 0), a2, voffA);
            PG8_WAIT_V(8); PG8_WAIT_L(0); PG8_BAR; PG8_MMA(1, 0, At, B0); PG8_MMA(1, 1, At, B1); PG8_BAR; PG8_SCHED;
            PG8_LDB(B0, 1, 0); PG8_LDB(B1, 1, 1); PG8_SCHED; PG8_LDA(At, 1, 0); PG8_STAGE(PG8_SA(0, 1), a2 + hsA, voffA);
            PG8_WAIT_V(8); PG8_WAIT_L(0); PG8_BAR; PG8_MMA(0, 0, At, B0); PG8_MMA(0, 1, At, B1); PG8_BAR; PG8_SCHED;
            PG8_LDA(At, 1, 1); PG8_STAGE(PG8_SB(1, 0), b3, voffB); PG8_STAGE(PG8_SB(1, 1), b3 + hsB, voffB); PG8_STAGE(PG8_SA(1, 0), a3, voffA);
            PG8_WAIT_V(8); PG8_WAIT_L(0); PG8_BAR;
            if constexpr (Epi::HAS_PRE) { if (last) E.preload(cur, wr, wc, pre); }
            PG8_MMA(1, 0, At, B0); PG8_MMA(1, 1, At, B1); PG8_BAR; PG8_SCHED;
        }
        if (wr == 0) PG8_BAR;
        { int ln; asm volatile("v_mbcnt_lo_u32_b32 %0, -1, 0\n\tv_mbcnt_hi_u32_b32 %0, -1, %0" : "=v"(ln));
          if constexpr (Epi::HAS_PRE) E(acc, cur, wr, wc, ln & 15, ln >> 4, pre); else E(acc, cur, wr, wc, ln & 15, ln >> 4); }
        if (!has_next) break;
#pragma unroll
        for (int a = 0; a < 2; ++a)
#pragma unroll
            for (int b = 0; b < 2; ++b)
#pragma unroll
                for (int m = 0; m < 4; ++m)
#pragma unroll
                    for (int n = 0; n < 2; ++n) acc[a][b][m][n] = (f32x4){0.f, 0.f, 0.f, 0.f};
        cur = nxt; cA = nA; cB = nB; ++ui;
        if (wr == 1) PG8_BAR;
    }
    PG8_WAIT_V(0);
    PG8_BAR;
#undef PG8_SA
#undef PG8_SB
#undef PG8_STAGE
#undef PG8_LDA
#undef PG8_LDB
#undef PG8_MMA
#undef PG8_WAIT_V
#undef PG8_WAIT_L
#undef PG8_BAR
#undef PG8_SCHED
#undef PG8_BASEA
#undef PG8_BASEB
}
}

namespace attn_body {
using bf16=__hip_bfloat16;
using bf16x8=__attribute__((ext_vector_type(8)))short;
using s16x4=__attribute__((ext_vector_type(4)))short;
using f32x16=__attribute__((ext_vector_type(16)))float;
using u32x4=__attribute__((ext_vector_type(4)))unsigned;
constexpr int SEQ=2048,D=64;
constexpr int QP=1536, OP=1024;
constexpr int NW=8,QBLK=32,QB=QBLK*NW,KVBLK=64,NQB=SEQ/QB;
__device__ __forceinline__ int crow(int r,int hi){return (r&3)+8*(r>>2)+4*hi;}
#define SBAR() __builtin_amdgcn_sched_barrier(0)
__device__ __forceinline__ void cmask(f32x16&p0,f32x16&p1,int jb,int qrel,int hi){
  const float NEG=-INFINITY; int kb=64*jb+4*hi;
  #pragma unroll
  for(int r=0;r<16;++r){int kv=kb+(r&3)+8*(r>>2); if(kv>qrel)p0[r]=NEG; if(kv+32>qrel)p1[r]=NEG;}
}
constexpr int NSLOT=3, SLOTB=8192, VSLOTB=16384;
constexpr int LDS_K=0, LDS_V=NSLOT*SLOTB, LDS_WS=LDS_V+NSLOT*VSLOTB, LDS_OST=LDS_WS+NW*64*4, LDS_BYTES=LDS_OST+NW*4096;
constexpr float C2=0.125f*1.4426950408889634f;
__device__ __forceinline__ void glds16(const void*gbase,unsigned voff,unsigned lds_dst){unsigned keep;
  asm volatile("s_mov_b32 %0, m0\n\ts_mov_b32 m0, %3\n\ts_nop 0\n\tglobal_load_lds_dwordx4 %1, %2\n\ts_mov_b32 m0, %0":"=&s"(keep):"v"(voff),"s"(gbase),"s"(lds_dst):"memory");}
__device__ __forceinline__ float max3f(float a,float b,float c){float r;asm("v_max3_f32 %0, %1, %2, %3":"=v"(r):"v"(a),"v"(b),"v"(c));return r;}
__device__ __forceinline__ float max2f(float a,float b){float r;asm("v_max_f32_e32 %0, %1, %2":"=v"(r):"v"(a),"v"(b));return r;}
__device__ __forceinline__ float fadd_s(float a,float b){float r;asm("v_add_f32_e32 %0, %1, %2":"=v"(r):"v"(a),"v"(b));return r;}
__device__ __forceinline__ float fsub_s(float a,float b){float r;asm("v_sub_f32_e32 %0, %1, %2":"=v"(r):"v"(a),"v"(b));return r;}
typedef float f32x2_t __attribute__((ext_vector_type(2))); typedef __bf16 bf16x2_t __attribute__((ext_vector_type(2)));
__device__ __forceinline__ unsigned cvtpk_s(float lo,float hi){f32x2_t v={lo,hi};bf16x2_t b=__builtin_convertvector(v,bf16x2_t);return __builtin_bit_cast(unsigned,b);}
#define WAIT_BAR(N) asm volatile("s_waitcnt vmcnt(" #N ") lgkmcnt(0)\n\ts_barrier":::"memory")

__device__ __forceinline__ void qkt(f32x16&p0,f32x16&p1,const char*Kslot,const bf16x8*qr,const f32x16&negm,int r32,int hi){
  const char*kb=Kslot+hi*1024+r32*16;
  #pragma unroll
  for(int d0=0;d0<4;++d0){
    const bf16x8 b0=*reinterpret_cast<const bf16x8*>(kb+d0*2048);
    const bf16x8 b1=*reinterpret_cast<const bf16x8*>(kb+d0*2048+512);
    if(d0==0){p0=__builtin_amdgcn_mfma_f32_32x32x16_bf16(b0,qr[0],negm,0,0,0);p1=__builtin_amdgcn_mfma_f32_32x32x16_bf16(b1,qr[0],negm,0,0,0);}
    else{p0=__builtin_amdgcn_mfma_f32_32x32x16_bf16(b0,qr[d0],p0,0,0,0);p1=__builtin_amdgcn_mfma_f32_32x32x16_bf16(b1,qr[d0],p1,0,0,0);}}
}
typedef __attribute__((address_space(3))) const char* lds_cptr;
typedef short v4i16_t __attribute__((ext_vector_type(4)));
__device__ __forceinline__ void kload8(bf16x8*kf,lds_cptr kp){
  kf[0]=*(const __attribute__((address_space(3))) bf16x8*)(kp);      kf[1]=*(const __attribute__((address_space(3))) bf16x8*)(kp+512);
  kf[2]=*(const __attribute__((address_space(3))) bf16x8*)(kp+2048); kf[3]=*(const __attribute__((address_space(3))) bf16x8*)(kp+2560);
  kf[4]=*(const __attribute__((address_space(3))) bf16x8*)(kp+4096); kf[5]=*(const __attribute__((address_space(3))) bf16x8*)(kp+4608);
  kf[6]=*(const __attribute__((address_space(3))) bf16x8*)(kp+6144); kf[7]=*(const __attribute__((address_space(3))) bf16x8*)(kp+6656);
}
__device__ __forceinline__ void kload2(bf16x8*kf,lds_cptr kp,int j){ kf[2*j]=*(const __attribute__((address_space(3))) bf16x8*)(kp+j*2048); kf[2*j+1]=*(const __attribute__((address_space(3))) bf16x8*)(kp+j*2048+512); }
__device__ __forceinline__ s16x4 vtr(lds_cptr p){ return __builtin_bit_cast(s16x4,__builtin_amdgcn_ds_read_tr16_b64_v4i16((__attribute__((address_space(3))) v4i16_t*)p)); }
__device__ __forceinline__ float rowmax(const f32x16&p0,const f32x16&p1){
  float a=max3f(p0[0],p0[1],p1[0]),b=max3f(p0[2],p0[3],p1[1]);a=max3f(a,p1[2],p1[3]);
  #pragma unroll
  for(int r=4;r<16;r+=4){a=max3f(a,p0[r],p0[r+1]);b=max3f(b,p0[r+2],p0[r+3]);a=max3f(a,p1[r],p1[r+1]);b=max3f(b,p1[r+2],p1[r+3]);}
  const float m=max2f(a,b);
  auto rr=__builtin_amdgcn_permlane32_swap(__float_as_uint(m),__float_as_uint(m),false,false);
  return max2f(__uint_as_float(rr[0]),__uint_as_float(rr[1]));
}
__device__ __forceinline__ void pv(f32x16*o,int vb,bf16x8 pa0,bf16x8 pa1,bf16x8 pa2,bf16x8 pa3){
  #pragma unroll
  for(int d0=0;d0<2;++d0){s16x4 lo[4],hi[4];
    #pragma unroll
    for(int ks=0;ks<4;++ks){
      asm volatile("ds_read_b64_tr_b16 %0,%1 offset:%c2":"=&v"(lo[ks]):"v"(vb),"i"(d0*4096+ks*1024):"memory");
      asm volatile("ds_read_b64_tr_b16 %0,%1 offset:%c2":"=&v"(hi[ks]):"v"(vb),"i"(d0*4096+ks*1024+512):"memory");}
    asm volatile("s_waitcnt lgkmcnt(0)":::"memory");SBAR();
    #define PK(k) (bf16x8){lo[k][0],lo[k][1],lo[k][2],lo[k][3],hi[k][0],hi[k][1],hi[k][2],hi[k][3]}
    o[d0]=__builtin_amdgcn_mfma_f32_32x32x16_bf16(pa0,PK(0),o[d0],0,0,0);
    o[d0]=__builtin_amdgcn_mfma_f32_32x32x16_bf16(pa1,PK(1),o[d0],0,0,0);
    o[d0]=__builtin_amdgcn_mfma_f32_32x32x16_bf16(pa2,PK(2),o[d0],0,0,0);
    o[d0]=__builtin_amdgcn_mfma_f32_32x32x16_bf16(pa3,PK(3),o[d0],0,0,0);
    #undef PK
  }
}
#define ATTN_STORE16(p,v) (*(u32x4*)(p)=(v))
template<int THRL> __device__ __forceinline__ void attn_unit(int b,int qb,const bf16*Qh,const bf16*__restrict__ Kh0,const bf16*__restrict__ Vh0,bf16*Oh,char*shm,int tid){
  asm volatile("":"+v"(tid)); const int lane=tid&63,r32=lane&31,hi=lane>>5; const int wid=__builtin_amdgcn_readfirstlane(tid>>6);
  const long rowbase=(long)b*SEQ; const int q0=qb*QB;
  const bf16*Qw=Qh+(rowbase+q0+wid*QBLK)*QP;
  const bf16*Kh=Kh0+rowbase*QP,*Vh=Vh0+rowbase*QP;
  const unsigned lds0=(unsigned)(uintptr_t)shm;
  float*wsf=(float*)(shm+LDS_WS)+wid*64;
  const unsigned koff=(unsigned)(lane*QP+wid*8)*2u;
  const unsigned voff=(unsigned)((16*(wid&3)+(lane>>2))*QP+(wid>>2)*32+(lane&3)*8)*2u;
  const unsigned kdst=lds0+LDS_K+wid*1024, vdst=lds0+LDS_V+wid*1024;
  #define DMA_K(t,slot) glds16(Kh+(long)(t)*KVBLK*QP,koff,(unsigned)__builtin_amdgcn_readfirstlane(kdst+(slot)))
  #define DMA_V(t,slot) do{ glds16(Vh+(long)(t)*KVBLK*QP,voff,(unsigned)__builtin_amdgcn_readfirstlane(vdst+2*(slot))); glds16(Vh+64+(long)(t)*KVBLK*QP,voff,(unsigned)__builtin_amdgcn_readfirstlane(vdst+2*(slot)+8192)); }while(0)
  const int vb0=(int)(lds0+LDS_V)+((lane>>4)&1)*32+(lane&3)*8+(4*hi+((lane&15)>>2))*64;
  const char*Kbase=shm+LDS_K; bf16x8 kf[8];
  const lds_cptr shm3=(lds_cptr)shm; const lds_cptr kp0=shm3+LDS_K+hi*1024+r32*16; const lds_cptr vp0=shm3+LDS_V+((lane>>4)&1)*32+(lane&3)*8+(4*hi+((lane&15)>>2))*64;
  const int NT=(q0+QB)/KVBLK;
  DMA_K(0,0);DMA_V(0,0);DMA_K(1,SLOTB);
  bf16x8 qr[4];
  #pragma unroll
  for(int d0=0;d0<4;++d0)qr[d0]=*reinterpret_cast<const bf16x8*>(&Qw[(long)r32*QP+d0*16+hi*8]);
  float mhat=0.f,l_reg=0.f;f32x16 o[4];o[0]=f32x16{};o[1]=f32x16{};o[2]=f32x16{};o[3]=f32x16{};const f32x16 negm=f32x16{};
  const int qrel=wid*QBLK+r32;
  #define CMASK(P0,P1,t) do{int jb_=(t)-(NT-4); if(jb_>=0)cmask(P0,P1,jb_,qrel,hi);}while(0)
  bool resc=false;
  #define START(P0,P1) do{ const float rm=rowmax(P0,P1); resc=false; \
    { const float dl=rm; mhat=fadd_s(mhat,dl); \
      _Pragma("unroll") for(int r=0;r<16;++r){P0[r]=fsub_s(P0[r],dl);P1[r]=fsub_s(P1[r],dl);} \
      } \
    _Pragma("unroll") for(int r=0;r<16;++r)P0[r]=__builtin_amdgcn_exp2f(P0[r]); }while(0)
  #define RESC() do{ if(resc){ asm volatile("s_waitcnt lgkmcnt(0)":::"memory"); \
      _Pragma("unroll") for(int d_=0;d_<4;++d_) _Pragma("unroll") for(int r=0;r<16;++r)o[d_][r]*=wsf[crow(r,hi)]; } }while(0)
  f32x16 pA0,pA1,pB0,pB1;
  int sl_prev=0,sl_cur=0,sl_next=SLOTB;
  #define ROT() do{sl_prev=sl_cur;sl_cur=sl_next;sl_next=(sl_next==(NSLOT-1)*SLOTB)?0:sl_next+SLOTB;}while(0)
  DMA_K(2,2*SLOTB);
  WAIT_BAR(3);
  qkt(pA0,pA1,Kbase,qr,negm,r32,hi);asm volatile("s_nop 15\n\ts_nop 7":"+v"(pA0),"+v"(pA1));CMASK(pA0,pA1,0);
  START(pA0,pA1);
  _Pragma("unroll") for(int r=0;r<16;++r)pA1[r]=__builtin_amdgcn_exp2f(pA1[r]);
  WAIT_BAR(0);
  DMA_K(3,0);DMA_V(1,SLOTB);
  ROT();
  kload8(kf,kp0+sl_cur);
  WAIT_BAR(3);
  s16x4 vlo[8],vhi[8]; u32x4 pw0,pw1,pw2,pw3;
  #define PKW(P,B) cvtpk_s(P[B],P[B+1])
  #define PAF(k) __builtin_bit_cast(bf16x8,pw##k)
  #define VFR(i) (bf16x8){vlo[i][0],vlo[i][1],vlo[i][2],vlo[i][3],vhi[i][0],vhi[i][1],vhi[i][2],vhi[i][3]}
  #define PIN(x) asm volatile("":"+v"(x))
  #define MX3(a,b,c) __builtin_fmaxf(__builtin_fmaxf((a),(b)),(c))
  #define GAPA(MF,A0,A1,A2,A3,W0,W1,PW) do{ MF; sacc+=A0; sacc+=A1; sacc+=A2; sacc+=A3; PIN(sacc); W0; W1; PIN(PW); SBAR(); }while(0)
  #define EX(v) __builtin_amdgcn_exp2f(v)
  #define GAPB(MF,X,B) do{ MF; X[B]=EX(X[B]); X[B+1]=EX(X[B+1]); X[B+2]=EX(X[B+2]); X[B+3]=EX(X[B+3]); PIN(X); SBAR(); }while(0)
  #define VRD(i) do{ vlo[i]=vtr(vp_+(((i)>>2)*4096+((i)&3)*1024)); vhi[i]=vtr(vp_+(((i)>>2)*4096+((i)&3)*1024+512)); }while(0)
  #define KRD(G,j) do{ if(G){ kload2(kf,kp0+sl_next,j); SBAR(); } }while(0)
  #define STEP(C0,C1,P0,P1,t,GK,GV,GL) do{ SBAR(); \
    const lds_cptr vp_=vp0+2*sl_prev; \
    VRD(0); SBAR(); float sacc=(P0[0]+P0[1]); \
    GAPA(C0=__builtin_amdgcn_mfma_f32_32x32x16_bf16(kf[0],qr[0],negm,0,0,0), P0[2],P0[3],P0[4],P0[5],     pw0[0]=PKW(P0,0), pw0[1]=PKW(P0,2), pw0); \
    VRD(4); SBAR(); GAPA(C1=__builtin_amdgcn_mfma_f32_32x32x16_bf16(kf[1],qr[0],negm,0,0,0), P0[6],P0[7],P0[8],P0[9],     pw0[2]=PKW(P0,4), pw0[3]=PKW(P0,6), pw0); \
    VRD(1); SBAR(); GAPA(C0=__builtin_amdgcn_mfma_f32_32x32x16_bf16(kf[2],qr[1],C0,0,0,0),   P0[10],P0[11],P0[12],P0[13], pw1[0]=PKW(P0,8), pw1[1]=PKW(P0,10), pw1); \
    VRD(5); SBAR(); GAPA(C1=__builtin_amdgcn_mfma_f32_32x32x16_bf16(kf[3],qr[1],C1,0,0,0),   P0[14],P0[15],P1[0],P1[1],   pw1[2]=PKW(P0,12),pw1[3]=PKW(P0,14), pw1); \
    VRD(2); SBAR(); GAPA(C0=__builtin_amdgcn_mfma_f32_32x32x16_bf16(kf[4],qr[2],C0,0,0,0),   P1[2],P1[3],P1[4],P1[5],     pw2[0]=PKW(P1,0), pw2[1]=PKW(P1,2), pw2); \
    VRD(6); SBAR(); GAPA(C1=__builtin_amdgcn_mfma_f32_32x32x16_bf16(kf[5],qr[2],C1,0,0,0),   P1[6],P1[7],P1[8],P1[9],     pw2[2]=PKW(P1,4), pw2[3]=PKW(P1,6), pw2); \
    VRD(3); SBAR(); GAPA(C0=__builtin_amdgcn_mfma_f32_32x32x16_bf16(kf[6],qr[3],C0,0,0,0),   P1[10],P1[11],P1[12],P1[13], pw3[0]=PKW(P1,8), pw3[1]=PKW(P1,10), pw3); \
    VRD(7); SBAR(); GAPA(C1=__builtin_amdgcn_mfma_f32_32x32x16_bf16(kf[7],qr[3],C1,0,0,0),   P1[14],P1[15],0.f,0.f,       pw3[2]=PKW(P1,12),pw3[3]=PKW(P1,14), pw3); \
    l_reg+=sacc; \
    if(GK){DMA_K((t)+3,sl_cur);} if(GV){DMA_V((t)+1,sl_next);} \
    _Pragma("unroll") for(int r=0;r<16;++r){C0[r]-=mhat;C1[r]-=mhat;} \
    CMASK(C0,C1,t); \
    { float a=MX3(C0[0],C0[1],C1[0]),b=MX3(C0[2],C0[3],C1[1]); a=MX3(a,C1[2],C1[3]); \
      _Pragma("unroll") for(int r=4;r<16;r+=4){a=MX3(a,C0[r],C0[r+1]);b=MX3(b,C0[r+2],C0[r+3]);a=MX3(a,C1[r],C1[r+1]);b=MX3(b,C1[r+2],C1[r+3]);} \
      float rm=__builtin_fmaxf(a,b); { auto rr=__builtin_amdgcn_permlane32_swap(__float_as_uint(rm),__float_as_uint(rm),false,false); rm=__builtin_fmaxf(__uint_as_float(rr[0]),__uint_as_float(rr[1])); } \
      resc=false; \
      if(__builtin_expect(__any(rm>(float)THRL),0)){ const float dl=__builtin_fmaxf(rm,0.f); mhat+=dl; \
        _Pragma("unroll") for(int r=0;r<16;++r){C0[r]-=dl;C1[r]-=dl;} \
        const float f=__builtin_amdgcn_exp2f(-dl); l_reg*=f; if(hi==0)wsf[r32]=f; resc=true; } } \
    SBAR(); \
    GAPB(o[0]=__builtin_amdgcn_mfma_f32_32x32x16_bf16(PAF(0),VFR(0),o[0],0,0,0), C0,0); \
    GAPB(o[1]=__builtin_amdgcn_mfma_f32_32x32x16_bf16(PAF(0),VFR(4),o[1],0,0,0), C0,4); \
    KRD(GL,0); GAPB(o[0]=__builtin_amdgcn_mfma_f32_32x32x16_bf16(PAF(1),VFR(1),o[0],0,0,0), C0,8); \
    KRD(GL,1); GAPB(o[1]=__builtin_amdgcn_mfma_f32_32x32x16_bf16(PAF(1),VFR(5),o[1],0,0,0), C0,12); \
    KRD(GL,2); GAPB(o[0]=__builtin_amdgcn_mfma_f32_32x32x16_bf16(PAF(2),VFR(2),o[0],0,0,0), C1,0); \
    KRD(GL,3); GAPB(o[1]=__builtin_amdgcn_mfma_f32_32x32x16_bf16(PAF(2),VFR(6),o[1],0,0,0), C1,4); \
    GAPB(o[0]=__builtin_amdgcn_mfma_f32_32x32x16_bf16(PAF(3),VFR(3),o[0],0,0,0), C1,8); \
    GAPB(o[1]=__builtin_amdgcn_mfma_f32_32x32x16_bf16(PAF(3),VFR(7),o[1],0,0,0), C1,12); \
    { const lds_cptr vq_=vp_+8192; \
      _Pragma("unroll") for(int i_=0;i_<8;++i_){ vlo[i_]=vtr(vq_+((i_>>2)*4096+(i_&3)*1024)); vhi[i_]=vtr(vq_+((i_>>2)*4096+(i_&3)*1024+512)); } SBAR(); \
      o[2]=__builtin_amdgcn_mfma_f32_32x32x16_bf16(PAF(0),VFR(0),o[2],0,0,0); o[3]=__builtin_amdgcn_mfma_f32_32x32x16_bf16(PAF(0),VFR(4),o[3],0,0,0); \
      o[2]=__builtin_amdgcn_mfma_f32_32x32x16_bf16(PAF(1),VFR(1),o[2],0,0,0); o[3]=__builtin_amdgcn_mfma_f32_32x32x16_bf16(PAF(1),VFR(5),o[3],0,0,0); \
      o[2]=__builtin_amdgcn_mfma_f32_32x32x16_bf16(PAF(2),VFR(2),o[2],0,0,0); o[3]=__builtin_amdgcn_mfma_f32_32x32x16_bf16(PAF(2),VFR(6),o[3],0,0,0); \
      o[2]=__builtin_amdgcn_mfma_f32_32x32x16_bf16(PAF(3),VFR(3),o[2],0,0,0); o[3]=__builtin_amdgcn_mfma_f32_32x32x16_bf16(PAF(3),VFR(7),o[3],0,0,0); SBAR(); } \
    }while(0)
  int t=1;
  #undef CMASK
  #define CMASK(P0,P1,t) do{}while(0)
  for(;t+5<NT;t+=2){
    STEP(pB0,pB1,pA0,pA1,t,true,true,true);     WAIT_BAR(3); RESC(); ROT();
    STEP(pA0,pA1,pB0,pB1,t+1,true,true,true);   WAIT_BAR(3); RESC(); ROT();
  }
  #undef CMASK
  #define CMASK(P0,P1,t) do{int jb_=(t)-(NT-4); if(jb_>=0)cmask(P0,P1,jb_,qrel,hi);}while(0)
  #define ENDW(tt) do{ if((tt)+3<NT){WAIT_BAR(3);} else if((tt)+2<NT){WAIT_BAR(2);} else {WAIT_BAR(0);} }while(0)
  for(;t+1<NT;t+=2){
    STEP(pB0,pB1,pA0,pA1,t,(t+3<NT),(t+1<NT),(t+1<NT));       ENDW(t);   RESC(); ROT();
    STEP(pA0,pA1,pB0,pB1,t+1,(t+4<NT),(t+2<NT),(t+2<NT));     ENDW(t+1); RESC(); ROT();
  }
  STEP(pB0,pB1,pA0,pA1,NT-1,false,false,false); RESC();
  { float sacc=pB0[0]+pB0[1]; _Pragma("unroll") for(int r=2;r<16;++r)sacc+=pB0[r]; _Pragma("unroll") for(int r=0;r<16;++r)sacc+=pB1[r]; l_reg+=sacc;
    pw0=(u32x4){PKW(pB0,0),PKW(pB0,2),PKW(pB0,4),PKW(pB0,6)};pw1=(u32x4){PKW(pB0,8),PKW(pB0,10),PKW(pB0,12),PKW(pB0,14)};pw2=(u32x4){PKW(pB1,0),PKW(pB1,2),PKW(pB1,4),PKW(pB1,6)};pw3=(u32x4){PKW(pB1,8),PKW(pB1,10),PKW(pB1,12),PKW(pB1,14)};
    SBAR(); pv(o,vb0+2*sl_cur,PAF(0),PAF(1),PAF(2),PAF(3)); pv(o+2,vb0+2*sl_cur+8192,PAF(0),PAF(1),PAF(2),PAF(3)); }
  #undef PKW
  #undef PAF
  #undef VFR
  #undef PIN
  #undef MX3
  #undef GAPA
  #undef GAPB
  #undef EX
  #undef VRD
  #undef KRD
  #undef STEP
  #undef ENDW
  {auto rr=__builtin_amdgcn_permlane32_swap(__float_as_uint(l_reg),__float_as_uint(l_reg),false,false);l_reg=__uint_as_float(rr[0])+__uint_as_float(rr[1]);}
  if(hi==0)wsf[32+r32]=l_reg;asm volatile("s_waitcnt lgkmcnt(0)":::"memory");
  float rli[16];
  #pragma unroll
  for(int r=0;r<16;++r)rli[r]=__builtin_amdgcn_rcpf(wsf[32+crow(r,hi)]);
  bf16*Ow=Oh+(rowbase+q0+wid*QBLK)*OP;
  { bf16*stg=(bf16*)(shm+LDS_OST)+wid*2048;
    #pragma unroll
    for(int ps_=0;ps_<2;++ps_){
      #pragma unroll
      for(int r=0;r<16;++r){const int orow=crow(r,hi);
        #pragma unroll
        for(int d0=0;d0<2;++d0)stg[orow*64+d0*32+r32]=__float2bfloat16(o[2*ps_+d0][r]*rli[r]);}
      asm volatile("s_waitcnt lgkmcnt(0)":::"memory");
      #pragma unroll
      for(int i=0;i<4;++i){const int row=i*8+(lane>>3),ch=lane&7; const u32x4 v=*(const u32x4*)(stg+row*64+ch*8); ATTN_STORE16(Ow+(long)row*OP+ps_*64+ch*8,v);}
      asm volatile("s_waitcnt lgkmcnt(0)":::"memory"); } }
  asm volatile("s_waitcnt lgkmcnt(0)\n\ts_barrier":::"memory");
  #undef DMA_K
  #undef DMA_V
  #undef CMASK
  #undef START
  #undef RESC
  #undef ROT
}
constexpr int ATTN_LDS_BYTES=LDS_BYTES;
#undef SBAR
#undef WAIT_BAR
}

constexpr int NWAVES = 8;
constexpr int NB = 16, SEQ = 2048, DM = 1024, DEPTH = 4, M = NB * SEQ;
constexpr int DSSM = 512, NG = 32, NP = 64, NCH = 16, TCH = 32, NCHUNK = SEQ / TCH;
constexpr int DFF = 2816, INCOLS = 2048;
constexpr int KY = 640;
constexpr float LN_EPS = 1e-5f, RMS_EPS = 1e-5f;
constexpr float ALPHA = 1.681792830507429f;

constexpr size_t MiB = 1u << 20;
constexpr size_t WS_CTL = 0, WS_STATS = 1 * MiB, CTL_ZERO_BYTES = 3 * MiB;
constexpr size_t WS_MOD = 3 * MiB;
constexpr size_t WS_ONES = 4 * MiB + 512 * 1024;
constexpr size_t WS_COS = 5 * MiB, WS_SIN = 6 * MiB;
constexpr size_t WS_CSBW = 7 * MiB;
constexpr size_t WS_GP = 11 * MiB;
constexpr size_t WS_GPINV = 11 * MiB + 512 * 1024;
constexpr size_t WS_MROWS = 12 * MiB;
constexpr size_t WS_W = 16 * MiB;
constexpr size_t W_IN = 0, W_GLU = W_IN + (size_t)2048 * 1024 * 2, W_OUT = W_GLU + (size_t)512 * 512 * 2, W_GU = W_OUT + (size_t)1024 * 1024 * 2,
                 W_DN = W_GU + (size_t)5632 * 1024 * 2, W_LAYER = W_DN + (size_t)1024 * 2816 * 2;
static_assert(W_LAYER == 23 * MiB, "weights per layer");
constexpr size_t WS_SSM = WS_W + 4 * W_LAYER;
constexpr size_t SSM_MF = 0, SSM_E = (size_t)32 * 512 * 640 * 2, SSM_LAYER = SSM_E + (size_t)32 * 128 * 512 * 2;
static_assert(SSM_LAYER == 24 * MiB, "ssm tables per layer");
constexpr size_t WS_H = WS_SSM + 4 * SSM_LAYER + 1 * MiB;
constexpr size_t WS_U = WS_H + 64 * MiB;
constexpr size_t WS_QKV = WS_U + 40 * MiB;
constexpr size_t WS_CAT = WS_QKV;
constexpr size_t WS_YACT = WS_QKV + 64 * MiB;
constexpr size_t WS_O2 = WS_QKV + 96 * MiB;
constexpr size_t WS_S = WS_O2 + 64 * MiB;
constexpr size_t WS_HDN = WS_QKV;
constexpr size_t WS_END = WS_S + 16 * MiB;
static_assert(WS_HDN + (size_t)M * DFF * 2 <= WS_END && WS_END <= 512 * MiB, "ws map");

constexpr int REP_A = 1, REP_B = 1, REP_C = 1, REP_D = 1, REP_F = 1;
constexpr int RING_BYTES = 131072, MISC_OFF = RING_BYTES + 320, LDS_BYTES = 147456;

#define GAS __attribute__((address_space(1)))
#define LAS __attribute__((address_space(3)))
typedef unsigned short bf16;
typedef unsigned v4u __attribute__((ext_vector_type(4)));
typedef unsigned v2u __attribute__((ext_vector_type(2)));
typedef float f32x4 __attribute__((ext_vector_type(4)));
#define LDS_WAIT() asm volatile("s_waitcnt lgkmcnt(0)" ::: "memory")
__device__ __forceinline__ float shx(float v, int mask, int lane) { return __builtin_bit_cast(float, __builtin_amdgcn_ds_bpermute((lane ^ mask) << 2, __builtin_bit_cast(int, v))); }
__device__ __forceinline__ unsigned f2bf(float f) { unsigned u = __builtin_bit_cast(unsigned, f); return (u + 0x7fffu + ((u >> 16) & 1u)) >> 16; }
__device__ __forceinline__ unsigned pk2(float lo, float hi) { return pg8::cvt_pk_bf16(lo, hi); }
typedef _Float16 h2_t __attribute__((ext_vector_type(2))); typedef float f2_t __attribute__((ext_vector_type(2)));
__device__ __forceinline__ unsigned pkh2(float lo, float hi) { const f2_t v = {lo, hi}; const h2_t h = __builtin_convertvector(v, h2_t); return __builtin_bit_cast(unsigned, h); }
__device__ __forceinline__ float hlo(unsigned w) { return (float)__builtin_bit_cast(h2_t, w)[0]; }
__device__ __forceinline__ float hhi(unsigned w) { return (float)__builtin_bit_cast(h2_t, w)[1]; }
__device__ __forceinline__ float bflo(unsigned w) { return __builtin_bit_cast(float, w << 16); }
__device__ __forceinline__ float bfhi(unsigned w) { return __builtin_bit_cast(float, w & 0xffff0000u); }

#define XB_TMO      128
#define XB_XCNT(j)  (256  + 64 * (j))
#define XB_XSUB(j)  (1280 + 64 * (j))
#define XB_XGEN(j)  (2304 + 64 * (j))
#define XB_TOP      3328
#define XB_TOPGEN   3392
#define XCD_BAR_WORDS 3456
#define XB_SPIN_CAP (1u << 20)
__device__ __forceinline__ unsigned xb_ld(unsigned* p)              { return __hip_atomic_load(p, __ATOMIC_RELAXED, __HIP_MEMORY_SCOPE_AGENT); }
__device__ __forceinline__ unsigned xb_add(unsigned* p, unsigned v) { return __hip_atomic_fetch_add(p, v, __ATOMIC_RELAXED, __HIP_MEMORY_SCOPE_AGENT); }
__device__ __forceinline__ unsigned xb_xcc_id() { return (unsigned)__builtin_amdgcn_s_getreg((3 << 11) | 20) & 0xFu; }
#define XB_SPIN(cond, bar) do { unsigned _sp = 0; while (cond) { __builtin_amdgcn_s_sleep(1); \
    if ((++_sp & 255u) == 0u) { if (xb_ld(&(bar)[XB_TMO])) break; if (_sp > XB_SPIN_CAP) { atomicAdd(&(bar)[XB_TMO], 1u); break; } } } } while (0)
struct XcdBarrier { unsigned* bar; unsigned x; volatile LAS unsigned* st; };
__device__ __forceinline__ int lane_fresh() { int l; asm volatile("v_mbcnt_lo_u32_b32 %0, -1, 0\n\tv_mbcnt_hi_u32_b32 %0, -1, %0" : "=v"(l)); return l; }
__device__ __forceinline__ bool xb_leader(int wave_s) { return wave_s == 0 && lane_fresh() == 0; }
__device__ __forceinline__ XcdBarrier xcd_barrier_post(unsigned* bar, volatile LAS unsigned* st, int wave_s) {
    XcdBarrier b; b.bar = bar; b.x = xb_xcc_id(); b.st = st;
    if (xb_leader(wave_s)) (void)xb_add(&bar[XB_XCNT(b.x)], 1u);
    return b;
}
__device__ __forceinline__ void xcd_barrier_complete(unsigned* bar, unsigned x, unsigned& nloc, unsigned& nx) {
    const unsigned G = gridDim.x * gridDim.y * gridDim.z;
    unsigned sum, cnt, mine, sp = 0u;
    for (;;) {
        sum = 0u; cnt = 0u; mine = 0u;
#pragma unroll
        for (unsigned j = 0; j < 16; ++j) { const unsigned c = xb_ld(&bar[XB_XCNT(j)]); sum += c; cnt += (c > 0u) ? 1u : 0u; mine = (j == x) ? c : mine; }
        if (sum == G) break;
        __builtin_amdgcn_s_sleep(1);
        if ((++sp & 255u) == 0u) { if (xb_ld(&bar[XB_TMO])) break; if (sp > XB_SPIN_CAP) { atomicAdd(&bar[XB_TMO], 1u); break; } }
    }
    nloc = mine > 0u ? mine : 1u; nx = cnt > 0u ? cnt : 1u;
}
__device__ __forceinline__ void xcd_barrier(const XcdBarrier& b, int wave_s) {
    asm volatile("s_waitcnt vmcnt(0)" ::: "memory");
    __syncthreads();
    if (xb_leader(wave_s)) {
        unsigned* bar = b.bar;
        __builtin_amdgcn_s_waitcnt(0);
        unsigned nloc = b.st[0], nx = b.st[1];
        if (nloc == 0u) { xcd_barrier_complete(bar, b.x, nloc, nx); b.st[0] = nloc; b.st[1] = nx; }
        const unsigned old = xb_add(&bar[XB_XSUB(b.x)], 1u);
        const unsigned gen = old / nloc;
        if (old + 1u == (gen + 1u) * nloc) {
            __builtin_amdgcn_fence(__ATOMIC_RELEASE, "agent");
            asm volatile("s_waitcnt vmcnt(0)" ::: "memory");
            const unsigned og = xb_add(&bar[XB_TOP], 1u);
            const unsigned tg = og / nx;
            if (og + 1u == (tg + 1u) * nx) xb_add(&bar[XB_TOPGEN], 1u);
            else XB_SPIN(xb_ld(&bar[XB_TOPGEN]) == tg, bar);
            __builtin_amdgcn_fence(__ATOMIC_ACQUIRE, "agent");
            xb_add(&bar[XB_XGEN(b.x)], 1u);
            asm volatile("s_waitcnt vmcnt(0)" ::: "memory");
        } else {
            XB_SPIN(xb_ld(&bar[XB_XGEN(b.x)]) == gen, bar);
            __builtin_amdgcn_fence(__ATOMIC_ACQUIRE, "agent");
            asm volatile("s_waitcnt vmcnt(0)" ::: "memory");
        }
    }
    __syncthreads();
}

using pg8::Unit; using pg8::bf16_t; using pg8::u32x4; using pg8::pack8; using pg8::sigm;
constexpr float LN_EPS_C = 1e-5f;

struct FixPre { float2 sv[2][4]; f32x4 cv[2], bv[2]; };
__device__ __forceinline__ void fix_preload(FixPre& P, const float* st, const float* cs_b, int pm, int wr, int colt_nofq) {
    const int ln = lane_fresh(), fr = ln & 15, fq = ln >> 4; const int row0 = pm * 256 + wr * 64 + fr; const float* csb = cs_b + colt_nofq + 8 * fq;
#pragma unroll
    for (int ai = 0; ai < 2; ++ai)
#pragma unroll
        for (int m = 0; m < 4; ++m) P.sv[ai][m] = *(const float2*)((const char*)st + 8u * (unsigned)(row0 + ai * 128 + m * 16));
#pragma unroll
    for (int n = 0; n < 2; ++n) { P.cv[n] = *(const f32x4*)(csb + 4 * n); P.bv[n] = *(const f32x4*)(csb + 16 * 7680 + 4 * n); }
}
__device__ __forceinline__ void fixup(f32x4 (&acc)[2][2][4][2], const FixPre& P, bool use, const float* csb) {
    float mu[2][4], rs[2][4];
    f32x4 cv1[2], bv1[2];
#pragma unroll
    for (int n = 0; n < 2; ++n) { cv1[n] = *(const f32x4*)(csb + 128 + 4 * n); bv1[n] = *(const f32x4*)(csb + 16 * 7680 + 128 + 4 * n); }
#pragma unroll
    for (int ai = 0; ai < 2; ++ai)
#pragma unroll
        for (int m = 0; m < 4; ++m) { const float mm = P.sv[ai][m].x * (1.f / 1024.f), rr = rsqrtf(P.sv[ai][m].y * (1.f / 1024.f) - mm * mm + LN_EPS_C); mu[ai][m] = use ? mm : 0.f; rs[ai][m] = use ? rr : 1.f; }
#pragma unroll
    for (int bj = 0; bj < 2; ++bj)
#pragma unroll
        for (int n = 0; n < 2; ++n) { const f32x4 cv = bj == 0 ? P.cv[n] : cv1[n], bv = bj == 0 ? P.bv[n] : bv1[n];
#pragma unroll
            for (int ai = 0; ai < 2; ++ai)
#pragma unroll
                for (int m = 0; m < 4; ++m) acc[ai][bj][m][n] = (acc[ai][bj][m][n] - cv * mu[ai][m]) * rs[ai][m] + bv; }
}
struct EpiInProj {
    static constexpr bool PERM = true;
    static constexpr bool HAS_PRE = true; typedef FixPre Pre;
    __device__ __forceinline__ void preload(const Unit& u, int wr, int wc, Pre& P) const { fix_preload(P, st, cs + (size_t)((u.pm * 256) >> 11) * 7680, u.pm, wr, u.pn * 256 + wc * 32); }
    __device__ __forceinline__ void prefetch(const Unit&, int, PG8_LAS unsigned char*) const {}
    bf16_t* Ug; bf16_t* QKV; const float* cosT; const float* sinT; float qscale;
    const float* st; const float* cs; int use_ln;
    __device__ __forceinline__ void operator()(f32x4 (&acc)[2][2][4][2], const Unit& u, int wr, int wc, int fr, int fq, const Pre& P) const {
        const int row0 = u.pm * 256 + wr * 64 + fr, colt = u.pn * 256 + wc * 32 + 8 * fq;
        fixup(acc, P, use_ln != 0, cs + (size_t)((u.pm * 256) >> 11) * 7680 + colt);
        if (u.pn < 2) {
#pragma unroll
            for (int ai = 0; ai < 2; ++ai)
#pragma unroll
                for (int m = 0; m < 4; ++m) { const int r = row0 + ai * 128 + m * 16, b = r >> 11, t = r & 2047, j = t >> 5, s = t & 31;
#pragma unroll
                    for (int bj = 0; bj < 2; ++bj) { const int c = colt + bj * 128, g = c >> 4, c0 = c & 15;
                        *(u32x4*)(Ug + ((size_t)(g * 1024 + b * 64 + j) * KY + s * 16 + c0)) = pack8(acc[ai][bj][m][0], acc[ai][bj][m][1]); } }
        } else {
            const bool rot = (u.pn < 6) && ((wc & 1) == 0) && (fq < 2);
            const float sc = (u.pn < 4) ? qscale : 1.f;
#pragma unroll
            for (int ai = 0; ai < 2; ++ai)
#pragma unroll
                for (int m = 0; m < 4; ++m) { const int r = row0 + ai * 128 + m * 16;
                    f32x4 cs = (f32x4){1.f, 1.f, 1.f, 1.f}, sn = (f32x4){0.f, 0.f, 0.f, 0.f};
                    if (rot) { cs = *(const f32x4*)(cosT + (size_t)r * 8 + 4 * fq); sn = *(const f32x4*)(sinT + (size_t)r * 8 + 4 * fq); }
#pragma unroll
                    for (int bj = 0; bj < 2; ++bj) { f32x4 v0 = acc[ai][bj][m][0], v1 = acc[ai][bj][m][1];
                        if (rot) { f32x4 a, b2;
                            a[0] = v0[0] * cs[0] - v0[1] * sn[0]; a[1] = v0[1] * cs[0] + v0[0] * sn[0]; a[2] = v0[2] * cs[1] - v0[3] * sn[1]; a[3] = v0[3] * cs[1] + v0[2] * sn[1];
                            b2[0] = v1[0] * cs[2] - v1[1] * sn[2]; b2[1] = v1[1] * cs[2] + v1[0] * sn[2]; b2[2] = v1[2] * cs[3] - v1[3] * sn[3]; b2[3] = v1[3] * cs[3] + v1[2] * sn[3];
                            v0 = a; v1 = b2; }
                        v0 = v0 * sc; v1 = v1 * sc;
                        *(u32x4*)(QKV + ((size_t)r * 1536 + (colt - 512) + bj * 128)) = pack8(v0, v1); } }
        }
    }
};
struct EpiSsmS {
    static constexpr bool PERM = false;
    static constexpr bool HAS_PRE = false; struct Pre {};
    __device__ __forceinline__ void prefetch(const Unit&, int, PG8_LAS unsigned char*) const {}
    float* S;
    __device__ __forceinline__ void operator()(f32x4 (&acc)[2][2][4][2], const Unit& u, int wr, int wc, int fr, int fq) const {
        const int row0 = u.pm * 256 + wr * 64 + fr, col0 = wc * 32 + 4 * fq;
#pragma unroll
        for (int ai = 0; ai < 2; ++ai)
#pragma unroll
            for (int m = 0; m < 4; ++m) { const int r = row0 + ai * 128 + m * 16;
#pragma unroll
                for (int n = 0; n < 2; ++n) *(f32x4*)(S + ((size_t)r * 128 + col0 + n * 16)) = acc[ai][0][m][n]; }
    }
};
__device__ __forceinline__ float gelu_tanh(float y) { const float x = 1.5957691216057308f * (y + 0.044715f * y * y * y); return y * sigm(x); }
struct EpiSsmY {
    static constexpr bool PERM = true;
    static constexpr bool HAS_PRE = false; struct Pre {};
    __device__ __forceinline__ void prefetch(const Unit&, int, PG8_LAS unsigned char*) const {}
    bf16_t* Y;
    __device__ __forceinline__ void operator()(f32x4 (&acc)[2][2][4][2], const Unit& u, int wr, int wc, int fr, int fq) const {
        const int row0 = u.pm * 256 + wr * 64 + fr, colt = u.pn * 256 + wc * 32 + 8 * fq;
#pragma unroll
        for (int ai = 0; ai < 2; ++ai)
#pragma unroll
            for (int m = 0; m < 4; ++m) { const int r = row0 + ai * 128 + m * 16, g = r >> 10, b = (r >> 6) & 15, j = r & 63;
#pragma unroll
                for (int bj = 0; bj < 2; ++bj) { const int c = colt + bj * 128, t = c >> 4, c0 = c & 15;
                    f32x4 v0 = acc[ai][bj][m][0], v1 = acc[ai][bj][m][1];
#pragma unroll
                    for (int e = 0; e < 4; ++e) { v0[e] = gelu_tanh(v0[e]); v1[e] = gelu_tanh(v1[e]); }
                    *(u32x4*)(Y + ((size_t)(b * 2048 + j * 32 + t) * 512 + g * 16 + c0)) = pack8(v0, v1); } }
    }
};
struct EpiGlu {
    static constexpr bool PERM = true;
    static constexpr bool HAS_PRE = false; struct Pre {};
    __device__ __forceinline__ void prefetch(const Unit&, int, PG8_LAS unsigned char*) const {}
    const bf16_t* Y; const float* bias; bf16_t* CAT;
    __device__ __forceinline__ void operator()(f32x4 (&acc)[2][2][4][2], const Unit& u, int wr, int wc, int fr, int fq) const {
        const int row0 = u.pm * 256 + wr * 64 + fr, colt = u.pn * 256 + wc * 32 + 8 * fq;
        f32x4 bv[2][2];
#pragma unroll
        for (int bj = 0; bj < 2; ++bj)
#pragma unroll
            for (int n = 0; n < 2; ++n) bv[bj][n] = *(const f32x4*)(bias + colt + bj * 128 + 4 * n);
#pragma unroll
        for (int ai = 0; ai < 2; ++ai)
#pragma unroll
            for (int m = 0; m < 4; ++m) { const int r = row0 + ai * 128 + m * 16;
#pragma unroll
                for (int bj = 0; bj < 2; ++bj) { const int c = colt + bj * 128;
                    const u32x4 yw = *(const u32x4*)(Y + ((size_t)r * 512 + c));
                    f32x4 g0 = acc[ai][bj][m][0] + bv[bj][0], g1 = acc[ai][bj][m][1] + bv[bj][1], o0, o1;
                    o0[0] = bflo(yw.x) * sigm(g0[0]); o0[1] = bfhi(yw.x) * sigm(g0[1]); o0[2] = bflo(yw.y) * sigm(g0[2]); o0[3] = bfhi(yw.y) * sigm(g0[3]);
                    o1[0] = bflo(yw.z) * sigm(g1[0]); o1[1] = bfhi(yw.z) * sigm(g1[1]); o1[2] = bflo(yw.w) * sigm(g1[2]); o1[3] = bfhi(yw.w) * sigm(g1[3]);
                    *(u32x4*)(CAT + ((size_t)r * 1024 + c)) = pack8(o0, o1); } }
    }
};
struct EpiResid {
    static constexpr bool PERM = true;
    static constexpr bool HAS_PRE = false; struct Pre {};
    __device__ __forceinline__ void prefetch(const Unit& u, int wid, PG8_LAS unsigned char* dummy) const {
        const int tid = wid * 64 + lane_fresh();
#pragma unroll
        for (int i = 0; i < 2; ++i) { const int q = tid + 512 * i, row = q >> 2, seg = q & 3;
            __builtin_amdgcn_global_load_lds((const unsigned*)(Hs + ((size_t)(u.pm * 256 + row) * 1024 + u.pn * 256 + seg * 64)), (PG8_LAS unsigned*)dummy, 4, 0, 0); }
    }
    bf16_t* Hs; const float* ginv; const float* st_in; const float* g_in; const float* b_in; const float* gate; float* st_out; const float* gp; int use_ln;
    __device__ __forceinline__ void operator()(f32x4 (&acc)[2][2][4][2], const Unit& u, int wr, int wc, int fr, int fq) const {
        const int row0 = u.pm * 256 + wr * 64 + fr, col0 = u.pn * 256 + wc * 32 + 8 * fq;
        const int b = (u.pm * 256) >> 11;
        const bool use = use_ln != 0;
        const unsigned e0 = (unsigned)row0 * 1024u + (unsigned)col0;
        char* H_c = (char*)Hs;
#define RES_LDP(P, BJ) do { _Pragma("unroll") for (int n = 0; n < 2; ++n) { const unsigned c = (unsigned)(col0 + (BJ) * 128 + 4 * n); \
            P[n][0] = *(const f32x4*)(gate + (unsigned)(b * 6144) + c); P[n][1] = *(const f32x4*)(ginv + (unsigned)(b * 1024) + c); P[n][2] = *(const f32x4*)(g_in + c); \
            P[n][3] = *(const f32x4*)(b_in + c); P[n][4] = *(const f32x4*)(gp + (unsigned)(b * 1024) + c); } } while (0)
#define RES_FIXP(P) do { _Pragma("unroll") for (int n = 0; n < 2; ++n) { P[n][0] = P[n][0] + 1.0f; \
            _Pragma("unroll") for (int e = 0; e < 4; ++e) { P[n][1][e] = use ? P[n][1][e] * P[n][2][e] : P[n][1][e]; P[n][2][e] = use ? P[n][2][e] : 0.f; P[n][3][e] = use ? P[n][3][e] : 0.f; } } } while (0)
#define RES_LDH(HV, BJ, AI) do { _Pragma("unroll") for (int m = 0; m < 4; ++m) \
            HV[AI][m] = *(const u32x4*)(H_c + 2u * (e0 + (unsigned)(((AI) * 128 + m * 16) * 1024 + (BJ) * 128))); } while (0)
#define RES_PROC(HV, P, BJ, AI) do { _Pragma("unroll") for (int m = 0; m < 4; ++m) { const u32x4 hw = HV[AI][m]; u32x4 w; \
            _Pragma("unroll") for (int n = 0; n < 2; ++n) { const unsigned w0 = n == 0 ? hw.x : hw.z, w1 = n == 0 ? hw.y : hw.w; f32x4 x; \
                x[0] = hlo(w0); x[1] = hhi(w0); x[2] = hlo(w1); x[3] = hhi(w1); \
                x = (x * P[n][1] - P[n][2] * mu[AI][m]) * rs[AI][m] + P[n][3]; \
                const f32x4 z = x * ALPHA + P[n][0] * acc[AI][BJ][m][n]; \
                ps[AI][m] += (z[0] + z[1]) + (z[2] + z[3]); pq[AI][m] += (z[0] * z[0] + z[1] * z[1]) + (z[2] * z[2] + z[3] * z[3]); \
                const f32x4 h = z * P[n][4]; const unsigned o0 = pkh2(h[0], h[1]), o1 = pkh2(h[2], h[3]); if (n == 0) { w.x = o0; w.y = o1; } else { w.z = o0; w.w = o1; } } \
            *(u32x4*)(H_c + 2u * (e0 + (unsigned)(((AI) * 128 + m * 16) * 1024 + (BJ) * 128))) = w; } } while (0)
        float2 sv[2][4]; f32x4 P0[2][5]; u32x4 hv0[2][4];
#pragma unroll
        for (int ai = 0; ai < 2; ++ai)
#pragma unroll
            for (int m = 0; m < 4; ++m) sv[ai][m] = *(const float2*)((const char*)st_in + 8u * (unsigned)(row0 + ai * 128 + m * 16));
        RES_LDP(P0, 0); RES_LDH(hv0, 0, 0);
        asm volatile("" ::: "memory");
        float mu[2][4], rs[2][4], ps[2][4], pq[2][4];
#pragma unroll
        for (int ai = 0; ai < 2; ++ai)
#pragma unroll
            for (int m = 0; m < 4; ++m) { ps[ai][m] = 0.f; pq[ai][m] = 0.f;
                const float mm = sv[ai][m].x * (1.f / 1024.f), rr = rsqrtf(sv[ai][m].y * (1.f / 1024.f) - mm * mm + LN_EPS_C); mu[ai][m] = use ? mm : 0.f; rs[ai][m] = use ? rr : 1.f; }
        RES_FIXP(P0);
        RES_PROC(hv0, P0, 0, 0);
        RES_LDH(hv0, 0, 1);
        asm volatile("" ::: "memory");
        RES_PROC(hv0, P0, 0, 1);
        f32x4 P1[2][5]; u32x4 hv1[2][4]; RES_LDP(P1, 1); RES_LDH(hv1, 1, 0); RES_LDH(hv1, 1, 1);
        asm volatile("" ::: "memory");
        RES_FIXP(P1);
        RES_PROC(hv1, P1, 1, 0); RES_PROC(hv1, P1, 1, 1);
#undef RES_LDP
#undef RES_FIXP
#undef RES_LDH
#undef RES_PROC
#pragma unroll
        for (int ai = 0; ai < 2; ++ai)
#pragma unroll
            for (int m = 0; m < 4; ++m) { float a = ps[ai][m], q = pq[ai][m];
                const int ln = lane_fresh();
                a += shx(a, 16, ln); a += shx(a, 32, ln); q += shx(q, 16, ln); q += shx(q, 32, ln);
                const int rb = u.pm * 256 + wr * 64 + (ln & 15);
                if ((ln >> 4) == 0) { float* sp = (float*)((char*)st_out + 8u * (unsigned)(rb + ai * 128 + m * 16)); unsafeAtomicAdd(sp, a); unsafeAtomicAdd(sp + 1, q); } }
    }
};
struct EpiCsBw {
    static constexpr bool PERM = false;
    static constexpr bool HAS_PRE = false; struct Pre {};
    __device__ __forceinline__ void prefetch(const Unit&, int, PG8_LAS unsigned char*) const {}
    float* out; int coff;
    __device__ __forceinline__ void operator()(f32x4 (&acc)[2][2][4][2], const Unit& u, int wr, int wc, int fr, int fq) const {
        if (wr != 0) return;
        const int col0 = coff + u.pn * 256 + wc * 32 + 4 * fq;
#pragma unroll
        for (int m = 0; m < 2; ++m)
#pragma unroll
            for (int bj = 0; bj < 2; ++bj)
#pragma unroll
                for (int n = 0; n < 2; ++n) *(f32x4*)(out + ((size_t)(u.pm * 32 + m * 16 + fr) * 7680 + col0 + bj * 128 + n * 16)) = acc[0][bj][m][n];
    }
};
struct EpiSwiGlu {
    static constexpr bool PERM = true;
    static constexpr bool HAS_PRE = true; typedef FixPre Pre;
    __device__ __forceinline__ void preload(const Unit& u, int wr, int wc, Pre& P) const { fix_preload(P, st, cs + (size_t)((u.pm * 256) >> 11) * 7680, u.pm, wr, u.pn * 256 + wc * 32); }
    __device__ __forceinline__ void prefetch(const Unit&, int, PG8_LAS unsigned char*) const {}
    bf16_t* Hd; const float* st; const float* cs;
    __device__ __forceinline__ void operator()(f32x4 (&acc)[2][2][4][2], const Unit& u, int wr, int wc, int fr, int fq, const Pre& P) const {
        const int row0 = u.pm * 256 + wr * 64 + fr, col = u.pn * 128 + wc * 32 + 8 * fq;
        fixup(acc, P, true, cs + (size_t)((u.pm * 256) >> 11) * 7680 + u.pn * 256 + wc * 32 + 8 * fq);
#pragma unroll
        for (int ai = 0; ai < 2; ++ai)
#pragma unroll
            for (int m = 0; m < 4; ++m) { const int r = row0 + ai * 128 + m * 16;
                f32x4 o0, o1;
#pragma unroll
                for (int e = 0; e < 4; ++e) { const float g0 = acc[ai][0][m][0][e], g1 = acc[ai][0][m][1][e];
                    o0[e] = g0 * sigm(g0) * acc[ai][1][m][0][e]; o1[e] = g1 * sigm(g1) * acc[ai][1][m][1][e]; }
                *(u32x4*)(Hd + ((size_t)r * DFF + col)) = pack8(o0, o1); }
    }
};

struct Args { const void* in[29]; float* out; unsigned char* ws; int ph_lo, ph_hi; };
enum { I_X = 0, I_C, I_POS, I_MODW, I_MODB, I_WIN, I_ARE, I_AIM, I_LOGSTEP, I_BRE, I_BIM, I_CRE, I_CIM, I_DSKIP, I_GLUW, I_GLUB,
       I_LQ1, I_LK1, I_LQ2, I_LK2, I_SUBLN, I_WOUT, I_LN1G, I_LN1B, I_WGATE, I_WUP, I_WDOWN, I_LN2G, I_LN2B };

__device__ __forceinline__ float wave_sum(float v, int lane) {
#pragma unroll
    for (int o = 1; o < 64; o <<= 1) v += shx(v, o, lane);
    return v;
}
__device__ __forceinline__ int map_row(int mode, int n) {
    if (mode == 1) { if (n >= 512 && n < 1536) { const int j = n & 63; if (j < 16) return (n - j) + ((j < 8) ? 2 * j : 2 * (j - 8) + 1); } return n; }
    if (mode == 2) return 256 * (n >> 7) + (n & 127);
    if (mode == 3) return 256 * (n >> 7) + 128 + (n & 127);
    return n;
}
__device__ __forceinline__ void transpose_item(const float* W, int K, int N, bf16* WT, int mode, LAS float* scr, int item, int lane, bool f16) {
    const int nblk = N / 128, kb = item / nblk, nb = item % nblk, k0 = 64 * kb, n0 = 128 * nb;
    const float* src = W + (size_t)k0 * N + n0 + lane;
    float v[2][64];
#pragma unroll
    for (int i = 0; i < 64; ++i) { v[0][i] = src[(size_t)i * N]; v[1][i] = src[(size_t)i * N + 64]; }
    const int c = lane & 7;
#pragma unroll
    for (int hh = 0; hh < 2; ++hh) {
#pragma unroll
        for (int i = 0; i < 32; ++i) scr[i * 65 + lane] = __builtin_bit_cast(float, f16 ? pkh2(v[hh][2 * i], v[hh][2 * i + 1]) : pk2(v[hh][2 * i], v[hh][2 * i + 1]));
        LDS_WAIT(); asm volatile("" ::: "memory");
#pragma unroll
        for (int j = 0; j < 8; ++j) { const int n = (lane >> 3) + 8 * j; const LAS float* s = scr + (4 * c) * 65 + n;
            v4u o; o.x = __builtin_bit_cast(unsigned, s[0]); o.y = __builtin_bit_cast(unsigned, s[65]); o.z = __builtin_bit_cast(unsigned, s[130]); o.w = __builtin_bit_cast(unsigned, s[195]);
            *(v4u*)(WT + (size_t)map_row(mode, n0 + 64 * hh + n) * K + k0 + 8 * c) = o; }
        LDS_WAIT(); asm volatile("" ::: "memory"); }
}

__device__ __forceinline__ void ssm_tables_unit(const Args& A, int l, int g, LAS float* L, bf16* MF, bf16* EE, int tid) {
    asm volatile("" : "+v"(tid)); const int lg = l * NG + g;
    LAS float* LR = L; LAS float* LI = L + 33 * 64; LAS float* BR = LI + 33 * 64; LAS float* BI = BR + 1024; LAS float* CR = BI + 1024; LAS float* CI = CR + 1024; LAS float* KT = CI + 1024;
    const float delta = expf(((const float*)A.in[I_LOGSTEP])[lg]);
    const float* are = (const float*)A.in[I_ARE] + lg * 64; const float* aim = (const float*)A.in[I_AIM] + lg * 64;
    for (int idx = tid; idx < 33 * 64; idx += 512) { const int tau = idx >> 6, p = idx & 63;
        const float lre = fminf(are[p], -1e-4f), lim = aim[p];
        const float mag = expf(lre * delta * (float)tau), ang = lim * delta * (float)tau; float s, c; sincosf(ang, &s, &c);
        LR[idx] = mag * c; LI[idx] = mag * s; }
    for (int idx = tid; idx < 1024; idx += 512) { const int p = idx >> 4, cc = idx & 15;
        const float lre = fminf(are[p], -1e-4f), lim = aim[p], x = lre * delta, y = lim * delta;
        float s, c; sincosf(y, &s, &c); const float sh = sinf(0.5f * y), ex = expf(x);
        const float nre = expm1f(x) * c - 2.f * sh * sh, nim = ex * s, den = lre * lre + lim * lim;
        const float kre = (nre * lre + nim * lim) / den, kim = (nim * lre - nre * lim) / den;
        const float bre = ((const float*)A.in[I_BRE])[(size_t)(lg * 64 + p) * 16 + cc], bim = ((const float*)A.in[I_BIM])[(size_t)(lg * 64 + p) * 16 + cc];
        BR[idx] = kre * bre - kim * bim; BI[idx] = kre * bim + kim * bre; }
    for (int idx = tid; idx < 1024; idx += 512) { CR[idx] = ((const float*)A.in[I_CRE])[(size_t)lg * 1024 + idx]; CI[idx] = ((const float*)A.in[I_CIM])[(size_t)lg * 1024 + idx]; }
    __syncthreads();
    { const int tau = tid >> 4, c = tid & 15; float a[16];
#pragma unroll
      for (int i = 0; i < 16; ++i) a[i] = 0.f;
      for (int p = 0; p < 64; ++p) { const float cr = CR[c * 64 + p], ci = CI[c * 64 + p], lr = LR[tau * 64 + p], li = LI[tau * 64 + p];
          const float gr = cr * lr - ci * li, gi = cr * li + ci * lr;
#pragma unroll
          for (int i = 0; i < 16; ++i) a[i] += gr * BR[p * 16 + i] - gi * BI[p * 16 + i]; }
      if (tau == 0) { const float d = ((const float*)A.in[I_DSKIP])[lg * 16 + c];
#pragma unroll
          for (int i = 0; i < 16; ++i) a[i] += (i == c) ? d : 0.f; }
#pragma unroll
      for (int i = 0; i < 16; ++i) KT[(tau * 16 + c) * 16 + i] = a[i]; }
    __syncthreads();
    for (int q = tid; q < 512 * 80; q += 512) { const int row = q / 80, cp = q - row * 80, t = row >> 4, c = row & 15; float v[8];
        if (cp < 64) { const int s = cp >> 1, c0 = (cp & 1) * 8;
#pragma unroll
            for (int i = 0; i < 8; ++i) v[i] = (s <= t) ? KT[((t - s) * 16 + c) * 16 + c0 + i] : 0.f;
        } else { const int pidx = (cp - 64) * 8, part = pidx >> 6, pp = pidx & 63;
#pragma unroll
            for (int i = 0; i < 8; ++i) { const int p = pp + i; const float cr = CR[c * 64 + p], ci = CI[c * 64 + p], lr = LR[(t + 1) * 64 + p], li = LI[(t + 1) * 64 + p];
                v[i] = part == 0 ? (cr * lr - ci * li) : -(cr * li + ci * lr); } }
        v4u o; o.x = pk2(v[0], v[1]); o.y = pk2(v[2], v[3]); o.z = pk2(v[4], v[5]); o.w = pk2(v[6], v[7]);
        *(v4u*)(MF + (size_t)row * KY + cp * 8) = o; }
    for (int q = tid; q < 128 * 64; q += 512) { const int rowp = q >> 6, cp = q & 63, part = rowp >> 6, p = rowp & 63, s = cp >> 1, c0 = (cp & 1) * 8, tau = 31 - s;
        const float lr = LR[tau * 64 + p], li = LI[tau * 64 + p]; float v[8];
#pragma unroll
        for (int i = 0; i < 8; ++i) { const float br = BR[p * 16 + c0 + i], bi = BI[p * 16 + c0 + i]; v[i] = part == 0 ? (lr * br - li * bi) : (lr * bi + li * br); }
        v4u o; o.x = pk2(v[0], v[1]); o.y = pk2(v[2], v[3]); o.z = pk2(v[4], v[5]); o.w = pk2(v[6], v[7]);
        *(v4u*)(EE + (size_t)rowp * 512 + cp * 8) = o; }
    __syncthreads();
}

__device__ __forceinline__ void mod_phase(const Args& A, LAS float* L, float* mod, int G, int tid) {
    asm volatile("" : "+v"(tid)); const int lane = tid & 63, wave = tid >> 6;
    LAS float* sc = L; LAS float* red = L + 16384;
    const float* c = (const float*)A.in[I_C];
    for (int idx = tid; idx < 16384; idx += 512) { const int b = idx >> 10, k = idx & 1023; const float v = c[idx]; sc[k * 16 + b] = v / (1.f + expf(-v)); }
    __syncthreads();
    for (int un = G - 1 - (int)blockIdx.x; un < DEPTH * 96; un += G) { const int l = un / 96, col = (un % 96) * 64 + lane;
        const float* W = (const float*)A.in[I_MODW] + (size_t)l * 1024 * 6144 + col;
        float a[16];
#pragma unroll
        for (int i = 0; i < 16; ++i) a[i] = 0.f;
        const int k0 = wave * 128;
#pragma unroll 32
        for (int k = k0; k < k0 + 128; ++k) { const float w = W[(size_t)k * 6144];
            const LAS f32x4* s4 = (const LAS f32x4*)(sc + k * 16);
#pragma unroll
            for (int q = 0; q < 4; ++q) { const f32x4 s = s4[q]; a[4 * q] += s[0] * w; a[4 * q + 1] += s[1] * w; a[4 * q + 2] += s[2] * w; a[4 * q + 3] += s[3] * w; } }
#pragma unroll
        for (int i = 0; i < 16; ++i) red[(wave * 16 + i) * 64 + lane] = a[i];
        __syncthreads();
        for (int o = tid; o < 1024; o += 512) { const int b = o >> 6, cl = o & 63; float s = 0.f;
#pragma unroll
            for (int w = 0; w < 8; ++w) s += red[(w * 16 + b) * 64 + cl];
            const int cg_ = (un % 96) * 64 + cl;
            mod[((size_t)l * 16 + b) * 6144 + cg_] = s + ((const float*)A.in[I_MODB])[l * 6144 + cg_]; }
        __syncthreads();
    }
}

__device__ __forceinline__ void modulate_rows(const float* x, const float* mod_l, int scale_off, bf16* H, int gw, int NGW, int lane) {
    for (int m0 = gw; m0 < M; m0 += 8 * NGW) {
        f32x4 v[8][4];
#pragma unroll
        for (int r = 0; r < 8; ++r) { const int m = (m0 + r * NGW < M) ? m0 + r * NGW : m0; const f32x4* xr = (const f32x4*)(x + (size_t)m * DM) + lane;
#pragma unroll
            for (int j = 0; j < 4; ++j) v[r][j] = xr[64 * j]; }
#pragma unroll
        for (int r = 0; r < 8; ++r) { const int m = m0 + r * NGW; if (m >= M) break; const int b = m >> 11;
            const f32x4* scp = (const f32x4*)(mod_l + (size_t)b * 6144 + scale_off) + lane; v2u* o8 = (v2u*)(H + (size_t)m * DM) + lane;
#pragma unroll
            for (int j = 0; j < 4; ++j) { const f32x4 h = v[r][j] * (scp[64 * j] + 1.0f); v2u w; w.x = pkh2(h[0], h[1]); w.y = pkh2(h[2], h[3]); o8[64 * j] = w; } } }
}
__device__ __forceinline__ void ln_rows_h(const bf16* Hh, float* out, const float* gam, const float* bet, int gw, int NGW, int lane) {
    const f32x4* g4 = (const f32x4*)gam + lane; const f32x4* b4 = (const f32x4*)bet + lane;
    for (int m0 = gw; m0 < M; m0 += 4 * NGW) {
        v2u w[4][4];
#pragma unroll
        for (int r = 0; r < 4; ++r) { const int m = (m0 + r * NGW < M) ? m0 + r * NGW : m0; const v2u* hr = (const v2u*)(Hh + (size_t)m * DM) + lane;
#pragma unroll
            for (int j = 0; j < 4; ++j) w[r][j] = hr[64 * j]; }
#pragma unroll
        for (int r = 0; r < 4; ++r) { const int m = m0 + r * NGW; if (m >= M) break; f32x4* xr = (f32x4*)(out + (size_t)m * DM) + lane;
            f32x4 v[4]; float s = 0.f;
#pragma unroll
            for (int j = 0; j < 4; ++j) { v[j][0] = hlo(w[r][j].x); v[j][1] = hhi(w[r][j].x); v[j][2] = hlo(w[r][j].y); v[j][3] = hhi(w[r][j].y); s += (v[j][0] + v[j][1]) + (v[j][2] + v[j][3]); }
            const float mean = wave_sum(s, lane) * (1.f / DM); float s2 = 0.f;
#pragma unroll
            for (int j = 0; j < 4; ++j) { v[j] = v[j] - mean; s2 += (v[j][0] * v[j][0] + v[j][1] * v[j][1]) + (v[j][2] * v[j][2] + v[j][3] * v[j][3]); }
            const float rstd = 1.f / sqrtf(wave_sum(s2, lane) * (1.f / DM) + LN_EPS);
#pragma unroll
            for (int j = 0; j < 4; ++j) xr[64 * j] = v[j] * rstd * g4[64 * j] + b4[64 * j]; } }
}

__global__ void __launch_bounds__(NWAVES * 64, 2) fwd_mega(Args args) {
    extern __shared__ __attribute__((aligned(16))) unsigned char lds[];
    LAS unsigned char* L = (LAS unsigned char*)lds;
    volatile LAS unsigned* MISC = (volatile LAS unsigned*)(L + MISC_OFF);
    if (args.ph_hi < 0) cg::this_grid().sync();
    const int G = gridDim.x, bx = blockIdx.x, NGW = G * NWAVES;
    const int wave_s = __builtin_amdgcn_readfirstlane((int)threadIdx.x >> 6);
    unsigned char* ws = args.ws;
    for (int u = threadIdx.x; u < (LDS_BYTES - RING_BYTES) / 4; u += NWAVES * 64) ((LAS unsigned*)(L + RING_BYTES))[u] = 0u;
#define PHASE_IDS() int tid = wave_s * 64 + lane_fresh(); asm volatile("" : "+v"(tid)); const int lane = tid & 63, wave = wave_s, gw = bx * NWAVES + wave; (void)lane; (void)gw
    __syncthreads();
    XcdBarrier bar = xcd_barrier_post((unsigned*)(ws + WS_CTL) + 1024, MISC + 8, wave_s);
#define RUN(k) (true)
#define ST(l_, s_) (STATS + (size_t)((l_) * 2 + (s_)) * M * 2)
#define SEAM() do { xcd_barrier(bar, wave_s); } while (0)

    float* CSBW = (float*)(ws + WS_CSBW); float* GP = (float*)(ws + WS_GP); float* GPINV = (float*)(ws + WS_GPINV); float* ONES = (float*)(ws + WS_ONES); bf16* MROWS = (bf16*)(ws + WS_MROWS); float* STATS = (float*)(ws + WS_STATS);
    float* mod = (float*)(ws + WS_MOD); float* cosT = (float*)(ws + WS_COS); float* sinT = (float*)(ws + WS_SIN);
    bf16* H = (bf16*)(ws + WS_H); bf16* Ug = (bf16*)(ws + WS_U); bf16* QKV = (bf16*)(ws + WS_QKV); bf16* CAT = (bf16*)(ws + WS_CAT);
    bf16* YACT = (bf16*)(ws + WS_YACT); bf16* O2 = (bf16*)(ws + WS_O2); float* Sb = (float*)(ws + WS_S); bf16* HDN = (bf16*)(ws + WS_HDN);
    const float* xin = (const float*)args.in[I_X]; float* X = args.out;

    if (RUN(ph)) { PHASE_IDS();
        for (int un = bx; un < DEPTH * NG; un += G) { const int l = un / NG, g = un % NG;
            ssm_tables_unit(args, l, g, (LAS float*)L, (bf16*)(ws + WS_SSM + (size_t)l * SSM_LAYER + SSM_MF) + (size_t)g * 512 * KY,
                            (bf16*)(ws + WS_SSM + (size_t)l * SSM_LAYER + SSM_E) + (size_t)g * 128 * 512, tid); }
        __syncthreads();
        mod_phase(args, (LAS float*)L, mod, G, tid);
        for (int idx = bx * 512 + tid; idx < M * 8; idx += G * 512) { const int row = idx >> 3, i = idx & 7;
            const float freq = powf(500000.0f, -(float)i * 0.125f), ang = (float)((const int*)args.in[I_POS])[row] * freq; float s, c; sincosf(ang, &s, &c);
            cosT[idx] = c; sinT[idx] = s; }
        __syncthreads();
        LAS float* scr = (LAS float*)(L + wave * 16384);
        constexpr int IT_IN = 16 * 16, IT_GLU = 8 * 4, IT_OUT = 16 * 8, IT_G = 16 * 22, IT_D = 44 * 8, IT_L = IT_IN + IT_GLU + IT_OUT + 2 * IT_G + IT_D;
        unsigned* wq = (unsigned*)(ws + WS_CTL) + 64;
        volatile LAS int* qslot = (volatile LAS int*)(L + RING_BYTES + 8192); int par = 0;
        int nxtb = 0; if (tid == 0) nxtb = (int)__hip_atomic_fetch_add(wq, 8u, __ATOMIC_RELAXED, __HIP_MEMORY_SCOPE_AGENT);
        for (;;) { if (tid == 0) qslot[par] = nxtb;
            __syncthreads();
            const int base = qslot[par]; par ^= 1;
            if (base >= DEPTH * IT_L) break;
            if (tid == 0) nxtb = (int)__hip_atomic_fetch_add(wq, 8u, __ATOMIC_RELAXED, __HIP_MEMORY_SCOPE_AGENT);
            const int it = base + wave; if (it >= DEPTH * IT_L) continue;
            const int l = it / IT_L; int r = it % IT_L; unsigned char* wl = ws + WS_W + (size_t)l * W_LAYER;
            if (r < IT_IN) { transpose_item((const float*)args.in[I_WIN] + (size_t)l * 1024 * 2048, 1024, 2048, (bf16*)(wl + W_IN), 1, scr, r, lane, true); continue; } r -= IT_IN;
            if (r < IT_GLU) { transpose_item((const float*)args.in[I_GLUW] + (size_t)l * 512 * 512, 512, 512, (bf16*)(wl + W_GLU), 0, scr, r, lane, false); continue; } r -= IT_GLU;
            if (r < IT_OUT) { transpose_item((const float*)args.in[I_WOUT] + (size_t)l * 1024 * 1024, 1024, 1024, (bf16*)(wl + W_OUT), 0, scr, r, lane, false); continue; } r -= IT_OUT;
            if (r < IT_G) { transpose_item((const float*)args.in[I_WGATE] + (size_t)l * 1024 * DFF, 1024, DFF, (bf16*)(wl + W_GU), 2, scr, r, lane, true); continue; } r -= IT_G;
            if (r < IT_G) { transpose_item((const float*)args.in[I_WUP] + (size_t)l * 1024 * DFF, 1024, DFF, (bf16*)(wl + W_GU), 3, scr, r, lane, true); continue; } r -= IT_G;
            transpose_item((const float*)args.in[I_WDOWN] + (size_t)l * DFF * 1024, DFF, 1024, (bf16*)(wl + W_DN), 0, scr, r, lane, false); }
    }
    SEAM();
    if (RUN(ph)) { PHASE_IDS();
        for (int idx = bx * 512 + tid; idx < 16 * 1024; idx += G * 512) ONES[idx] = 1.0f;
        for (int idx = bx * 512 + tid; idx < DEPTH * 2 * 16 * 1024; idx += G * 512) { const int k = idx & 1023, b = (idx >> 10) & 15, sub = (idx >> 14) & 1, l = idx >> 15;
            float g = 1.f, bb = 0.f, sc, sh; const float* ml = mod + ((size_t)l * 16 + b) * 6144;
            if (sub == 0) { if (l > 0) { g = ((const float*)args.in[I_LN2G])[(l - 1) * 1024 + k]; bb = ((const float*)args.in[I_LN2B])[(l - 1) * 1024 + k]; } sh = ml[k]; sc = ml[1024 + k]; }
            else { g = ((const float*)args.in[I_LN1G])[l * 1024 + k]; bb = ((const float*)args.in[I_LN1B])[l * 1024 + k]; sh = ml[3072 + k]; sc = ml[4096 + k]; }
            const float gpr = g * (1.f + sc), bpr = bb * (1.f + sc) + sh;
            GP[idx] = gpr; GPINV[idx] = 1.0f / gpr;
            bf16* mr = MROWS + ((size_t)(sub * DEPTH + l) * 256) * 1024; mr[(size_t)b * 1024 + k] = (bf16)(pkh2(gpr, 0.f) & 0xffffu); mr[(size_t)(16 + b) * 1024 + k] = (bf16)(pkh2(bpr, 0.f) & 0xffffu); }
    }
    SEAM();
    if (RUN(ph)) { PHASE_IDS();
        { pg8::Gemm g{MROWS, (const bf16*)(ws + WS_W + W_IN), DEPTH * 256, INCOLS, 1024, 1024, 1024, 1, W_LAYER / 2}; pg8::StaticOrder S; S.init(DEPTH * 256, INCOLS, G, bx);
          EpiCsBw E{CSBW, 0}; pg8::gemm_phase<EpiCsBw, pg8::StaticOrder, true>(L, g, S, E, tid); }
        { pg8::Gemm g{MROWS + (size_t)DEPTH * 256 * 1024, (const bf16*)(ws + WS_W + W_GU), DEPTH * 256, 2 * DFF, 1024, 1024, 1024, 1, W_LAYER / 2}; pg8::StaticOrder S; S.init(DEPTH * 256, 2 * DFF, G, G - 1 - bx);
          EpiCsBw E{CSBW, 2048}; pg8::gemm_phase<EpiCsBw, pg8::StaticOrder, true>(L, g, S, E, tid); }
        modulate_rows(xin, mod, 1024, H, gw, NGW, lane);
    }
    SEAM();

    for (int l = 0; l < DEPTH; ++l) {
        unsigned char* wl = ws + WS_W + (size_t)l * W_LAYER;
        const float* mod_l = mod + (size_t)l * 16 * 6144;
        const bf16* MF = (const bf16*)(ws + WS_SSM + (size_t)l * SSM_LAYER + SSM_MF); const bf16* EE = (const bf16*)(ws + WS_SSM + (size_t)l * SSM_LAYER + SSM_E);
        if (RUN(ph)) for (int rep = 0; rep < REP_A; ++rep) { PHASE_IDS(); pg8::Gemm g{H, (const bf16*)(wl + W_IN), M, INCOLS, 1024, 1024, 1024, 1 << 30, 0}; pg8::StaticOrder S; S.init(M, INCOLS, G, bx);
            EpiInProj E{Ug, QKV, cosT, sinT, attn_body::C2, l == 0 ? ST(0, 1) : ST(l - 1, 1), CSBW + (size_t)l * 32 * 7680, l == 0 ? 0 : 1}; pg8::gemm_phase<EpiInProj, pg8::StaticOrder, true>(L, g, S, E, tid); }
        SEAM();
        if (RUN(ph)) for (int rep = 0; rep < REP_B; ++rep) { PHASE_IDS();
            { pg8::Gemm g{Ug, EE, NG * 1024, 256, 512, KY, 512, 4, (size_t)128 * 512}; pg8::StaticOrder S; S.init(NG * 1024, 256, G, bx);
              EpiSsmS E{Sb}; pg8::gemm_phase<EpiSsmS, pg8::StaticOrder>(L, g, S, E, tid); }
            for (int it = bx; it < 128 * 8; it += G) { const int bhm = it & 127, sel = (it >> 7) & 1, kk = it >> 8, b = bhm >> 3, hm = bhm & 7, h = hm >> 1;
                const int qb = sel == 0 ? (kk == 0 ? 7 : kk == 1 ? 4 : kk == 2 ? 3 : 0) : (kk == 0 ? 6 : kk == 1 ? 5 : kk == 2 ? 2 : 1);
                attn_body::attn_unit<8>(b, qb, (const attn_body::bf16*)QKV + hm * 64, (const attn_body::bf16*)QKV + 512 + hm * 64,
                                        (const attn_body::bf16*)QKV + 1024 + h * 128, (attn_body::bf16*)O2 + hm * 128, (char*)lds, tid); }
        }
        SEAM();
        if (RUN(ph)) for (int rep = 0; rep < REP_C; ++rep) { PHASE_IDS(); pg8::Gemm g{Ug, MF, NG * 1024, 512, KY, KY, KY, 4, (size_t)512 * KY}; pg8::StaticOrder S; S.init(NG * 1024, 512, G, bx);
            { pg8::Unit uu; int last_pm = -1;
              for (int i = 0; S.next(i, uu); ++i) { if (uu.pm == last_pm) continue; last_pm = uu.pm;
                const int g_ = uu.pm >> 2, chain = tid & 255, half = tid >> 8, p = chain & 63, b_ = (uu.pm & 3) * 4 + (chain >> 6), lg = l * NG + g_;
                const float delta = expf(((const float*)args.in[I_LOGSTEP])[lg]);
                const float lre = fminf(((const float*)args.in[I_ARE])[lg * 64 + p], -1e-4f), lim = ((const float*)args.in[I_AIM])[lg * 64 + p];
                const float mag = expf(lre * delta * 32.f); float sn, cs; sincosf(lim * delta * 32.f, &sn, &cs); const float ar = mag * cs, ai = mag * sn;
                const unsigned rowa = (unsigned)(g_ * 1024 + b_ * 64 + half * 32);
                float sr[32], si[32];
#pragma unroll
                for (int j = 0; j < 32; ++j) { sr[j] = Sb[(rowa + j) * 128u + p]; si[j] = Sb[(rowa + j) * 128u + 64 + p]; }
                LAS float* xch = (LAS float*)L;
                float xr = 0.f, xi = 0.f;
                if (half == 0) {
#pragma unroll
                    for (int j = 0; j < 32; ++j) { bf16* up = Ug + (size_t)(rowa + j) * KY + 512 + p; up[0] = (bf16)f2bf(xr); up[64] = (bf16)f2bf(xi);
                        const float nr = ar * xr - ai * xi + sr[j], ni = ar * xi + ai * xr + si[j]; xr = nr; xi = ni; }
                    xch[chain * 2] = xr; xch[chain * 2 + 1] = xi; }
                __syncthreads();
                if (half == 1) { xr = xch[chain * 2]; xi = xch[chain * 2 + 1];
#pragma unroll
                    for (int j = 0; j < 32; ++j) { bf16* up = Ug + (size_t)(rowa + j) * KY + 512 + p; up[0] = (bf16)f2bf(xr); up[64] = (bf16)f2bf(xi);
                        const float nr = ar * xr - ai * xi + sr[j], ni = ar * xi + ai * xr + si[j]; xr = nr; xi = ni; } }
                __syncthreads(); }
              asm volatile("s_waitcnt vmcnt(0)" ::: "memory"); __syncthreads(); }
            EpiSsmY E{YACT}; pg8::gemm_phase<EpiSsmY, pg8::StaticOrder>(L, g, S, E, tid); }
        SEAM();
        if (RUN(ph)) for (int rep = 0; rep < REP_D; ++rep) { PHASE_IDS();
            { pg8::Gemm g{YACT, (const bf16*)(wl + W_GLU), M, 512, 512, 512, 512, 1 << 30, 0}; pg8::StaticOrder S; S.init(M, 512, G, bx);
              EpiGlu E{YACT, (const float*)args.in[I_GLUB] + l * 512, CAT}; pg8::gemm_phase<EpiGlu, pg8::StaticOrder>(L, g, S, E, tid); }
            const float lam_init = 0.8f - 0.6f * expf(-0.3f * (float)l);
            const float d1 = wave_sum(((const float*)args.in[I_LQ1])[l * 64 + lane] * ((const float*)args.in[I_LK1])[l * 64 + lane], lane);
            const float d2 = wave_sum(((const float*)args.in[I_LQ2])[l * 64 + lane] * ((const float*)args.in[I_LK2])[l * 64 + lane], lane);
            const float lam = expf(d1) - expf(d2) + lam_init;
            const int h = lane >> 4, e0 = (lane & 15) * 8; const float* sw = (const float*)args.in[I_SUBLN] + l * 128 + e0;
            float gn[8];
#pragma unroll
            for (int i = 0; i < 8; ++i) gn[i] = sw[i] * (1.f - lam_init);
            for (int m0 = gw; m0 < M; m0 += 8 * NGW) {
                v4u a[8], b2[8];
#pragma unroll
                for (int r = 0; r < 8; ++r) { const int m = (m0 + r * NGW < M) ? m0 + r * NGW : m0; a[r] = *(const v4u*)(O2 + (size_t)m * 1024 + h * 256 + e0); b2[r] = *(const v4u*)(O2 + (size_t)m * 1024 + h * 256 + 128 + e0); }
#pragma unroll
                for (int r = 0; r < 8; ++r) { const int m = m0 + r * NGW; if (m >= M) break;
                    float o[8]; o[0] = bflo(a[r].x) - lam * bflo(b2[r].x); o[1] = bfhi(a[r].x) - lam * bfhi(b2[r].x); o[2] = bflo(a[r].y) - lam * bflo(b2[r].y); o[3] = bfhi(a[r].y) - lam * bfhi(b2[r].y);
                    o[4] = bflo(a[r].z) - lam * bflo(b2[r].z); o[5] = bfhi(a[r].z) - lam * bfhi(b2[r].z); o[6] = bflo(a[r].w) - lam * bflo(b2[r].w); o[7] = bfhi(a[r].w) - lam * bfhi(b2[r].w);
                    float ss = 0.f;
#pragma unroll
                    for (int i = 0; i < 8; ++i) ss += o[i] * o[i];
                    ss += shx(ss, 1, lane); ss += shx(ss, 2, lane); ss += shx(ss, 4, lane); ss += shx(ss, 8, lane);
                    const float rs = 1.f / sqrtf(ss * (1.f / 128.f) + RMS_EPS);
                    v4u w; w.x = pk2(o[0] * rs * gn[0], o[1] * rs * gn[1]); w.y = pk2(o[2] * rs * gn[2], o[3] * rs * gn[3]); w.z = pk2(o[4] * rs * gn[4], o[5] * rs * gn[5]); w.w = pk2(o[6] * rs * gn[6], o[7] * rs * gn[7]);
                    *(v4u*)(CAT + (size_t)m * 1024 + 512 + h * 128 + e0) = w; } }
        }
        SEAM();
        if (RUN(ph)) { PHASE_IDS(); pg8::Gemm g{CAT, (const bf16*)(wl + W_OUT), M, 1024, 1024, 1024, 1024, 1 << 30, 0}; pg8::StaticOrder S; S.init(M, 1024, G, bx);
            EpiResid E{H, GPINV + (size_t)(l * 2) * 16 * 1024, l == 0 ? ST(0, 1) : ST(l - 1, 1), (const float*)args.in[I_LN2G] + (l > 0 ? l - 1 : 0) * 1024, (const float*)args.in[I_LN2B] + (l > 0 ? l - 1 : 0) * 1024,
                       mod_l + 2048, ST(l, 0), GP + (size_t)(l * 2 + 1) * 16 * 1024, l == 0 ? 0 : 1};
            pg8::gemm_phase<EpiResid, pg8::StaticOrder>(L, g, S, E, tid); }
        SEAM();
        if (RUN(ph)) for (int rep = 0; rep < REP_F; ++rep) { PHASE_IDS(); pg8::Gemm g{H, (const bf16*)(wl + W_GU), M, 2 * DFF, 1024, 1024, 1024, 1 << 30, 0}; pg8::StaticOrder S; S.init(M, 2 * DFF, G, bx);
            EpiSwiGlu E{HDN, ST(l, 0), CSBW + (size_t)l * 32 * 7680 + 2048}; pg8::gemm_phase<EpiSwiGlu, pg8::StaticOrder, true>(L, g, S, E, tid); }
        SEAM();
        if (RUN(ph)) { PHASE_IDS(); pg8::Gemm g{HDN, (const bf16*)(wl + W_DN), M, 1024, DFF, DFF, DFF, 1 << 30, 0}; pg8::StaticOrder S; S.init(M, 1024, G, bx);
            EpiResid E{H, GPINV + (size_t)(l * 2 + 1) * 16 * 1024, ST(l, 0), (const float*)args.in[I_LN1G] + l * 1024, (const float*)args.in[I_LN1B] + l * 1024,
                       mod_l + 5120, ST(l, 1), (l + 1 < DEPTH) ? GP + (size_t)((l + 1) * 2) * 16 * 1024 : ONES, 1};
            pg8::gemm_phase<EpiResid, pg8::StaticOrder>(L, g, S, E, tid); }
        SEAM();
    }
    if (RUN(ph)) { PHASE_IDS(); ln_rows_h(H, X, (const float*)args.in[I_LN2G] + 3 * 1024, (const float*)args.in[I_LN2B] + 3 * 1024, gw, NGW, lane); }
#undef RUN
#undef SEAM
#undef ST
}

#ifndef N_LAUNCHES
#define N_LAUNCHES 1
#endif
constexpr int N_PHASES = 3 + DEPTH * 7 + 1;

extern "C" void kernel_launch(void* const* d_in, const int* in_sizes, int n_in, void* d_out, int out_size, void* d_ws, size_t ws_size, hipStream_t stream) {
    static int grid = 0;
    if (grid == 0) {
        if (n_in != 29 || out_size != M * DM || ws_size < WS_END) { fprintf(stderr, "kernel_launch: unexpected problem (n_in %d out %d ws %zu)\n", n_in, out_size, ws_size); grid = -1; return; }
        int dev = 0, cus = 0, per_cu = 0;
        hipGetDevice(&dev); hipDeviceGetAttribute(&cus, hipDeviceAttributeMultiprocessorCount, dev);
        if (hipFuncSetAttribute((const void*)fwd_mega, hipFuncAttributeMaxDynamicSharedMemorySize, LDS_BYTES) != hipSuccess) { fprintf(stderr, "kernel_launch: hipFuncSetAttribute failed\n"); grid = -1; return; }
        if (hipOccupancyMaxActiveBlocksPerMultiprocessor(&per_cu, (const void*)fwd_mega, NWAVES * 64, LDS_BYTES) != hipSuccess || per_cu < 1) { fprintf(stderr, "kernel_launch: occupancy query says %d\n", per_cu); per_cu = 1; }
        (void)hipGetLastError();
        grid = cus;
    }
    if (grid < 0) return;
    (void)hipMemsetAsync((char*)d_ws + WS_CTL, 0, CTL_ZERO_BYTES, stream);
    Args a{};
    for (int i = 0; i < 29; ++i) a.in[i] = d_in[i];
    a.out = (float*)d_out; a.ws = (unsigned char*)d_ws;
    {
        a.ph_lo = 0; a.ph_hi = N_PHASES;
        void* kargs[] = {&a};
        hipError_t e = hipLaunchCooperativeKernel((const void*)fwd_mega, dim3(grid), dim3(NWAVES * 64), kargs, LDS_BYTES, stream);
        if (e != hipSuccess) fprintf(stderr, "cooperative launch failed: %s (grid %d)\n", hipGetErrorString(e), grid);
    }
}
```

```cpp
#include <hip/hip_runtime.h>
#include <hip/hip_cooperative_groups.h>
#include <hip/hip_bf16.h>
#include <cstdio>
#include <cstdint>
#include <cmath>
namespace cg = cooperative_groups;

namespace pg8 {
#define PG8_LAS __attribute__((address_space(3)))
typedef unsigned short bf16_t;
typedef short bf16x8 __attribute__((ext_vector_type(8)));
typedef float f32x4 __attribute__((ext_vector_type(4)));
typedef unsigned u32x4 __attribute__((ext_vector_type(4)));
constexpr int BM = 256, BK = 64, HALF = 128, HTB = HALF * BK * 2, STAGE_BYTES = 8 * HTB, NXCD = 8, WGM = 8;

__host__ __device__ __forceinline__ int lds_byte(int r, int c) { const int st = (r >> 4) * 2 + (c >> 5), rr = r & 15, cc = c & 31, ob = rr * 64 + cc * 2; return st * 1024 + (ob ^ (((ob >> 9) & 1) << 5)); }
__host__ __device__ __forceinline__ void stage_rc(int b, int& R, int& C) { const int st = b / 1024, sb = b % 1024, swz = sb ^ (((sb >> 9) & 1) << 5); R = (st >> 1) * 16 + swz / 64; C = (st & 1) * 32 + (swz % 64) / 2; }
__host__ __device__ __forceinline__ int perm32(int rho) { const int n = rho >> 4, i = rho & 15; return 8 * (i >> 2) + 4 * n + (i & 3); }

struct Unit { int pm, pn; };
struct Gemm { const bf16_t* A; const bf16_t* Bt; int M, N, K, lda, ldb, pm_per_batch; size_t bstrideB; };

struct StaticOrder {
    int nM, nN, nwg, G, c;
    __host__ __device__ void init(int M, int N, int G_, int c_) { nM = M / BM; nN = N / BM; nwg = nM * nN; G = G_; c = c_; }
    __host__ __device__ bool next(int i, Unit& u) const {
        const long L = (long)i * G + c; if (L >= nwg) return false;
        int wgid = (int)L; { const int q = nwg / NXCD, r = nwg % NXCD, xcd = wgid % NXCD, off = wgid / NXCD; wgid = (xcd < r ? xcd * (q + 1) : r * (q + 1) + (xcd - r) * q) + off; }
        const int nig = WGM * nN, gid = wgid / nig, fm = gid * WGM, gsz = (nM - fm) < WGM ? (nM - fm) : WGM;
        u.pm = fm + ((wgid % nig) % gsz); u.pn = (wgid % nig) / gsz; return true;
    }
};

__device__ __forceinline__ unsigned cvt_pk_bf16(float lo, float hi) { unsigned r; asm volatile("v_cvt_pk_bf16_f32 %0, %1, %2" : "=v"(r) : "v"(lo), "v"(hi)); return r; }
__device__ __forceinline__ u32x4 pack8(const f32x4 v0, const f32x4 v1) { u32x4 w; w.x = cvt_pk_bf16(v0[0], v0[1]); w.y = cvt_pk_bf16(v0[2], v0[3]); w.z = cvt_pk_bf16(v1[0], v1[1]); w.w = cvt_pk_bf16(v1[2], v1[3]); return w; }
__device__ __forceinline__ float sigm(float x) { return __builtin_amdgcn_rcpf(1.0f + __expf(-x)); }


typedef _Float16 f16x8 __attribute__((ext_vector_type(8)));
template <class Epi, class Sched, bool F16 = false>
__device__ __forceinline__ void gemm_phase(PG8_LAS unsigned char* lds, const Gemm g, const Sched& S, const Epi& E, int tid) {
    asm volatile("" : "+v"(tid));
    const int wid = __builtin_amdgcn_readfirstlane(tid >> 6), lane = tid & 63, wr = wid >> 2, wc = wid & 3, fr = lane & 15, fq = lane >> 4;
    const int K = g.K, nt = K / BK;
    unsigned voffA[2], voffB[2];
#pragma unroll
    for (int i = 0; i < 2; ++i) { int R, C; stage_rc(tid * 16 + i * 8192, R, C); const int Rb = Epi::PERM ? ((R & ~31) + perm32(R & 31)) : R;
        voffA[i] = (unsigned)(R * g.lda + C) * 2u; voffB[i] = (unsigned)(Rb * g.ldb + C) * 2u; }
    const size_t kstep = (size_t)(BK * 2);
    const size_t hsA = (size_t)HALF * g.lda * 2, hsB = (size_t)HALF * g.ldb * 2;
    const size_t tsA = 2 * hsA, tsB = 2 * hsB;
    const unsigned ldsw = (unsigned)wid * 1024u;
    const int aoff = lds_byte(wr * 64 + fr, fq * 8), boff = lds_byte(wc * 32 + fr, fq * 8);
#define PG8_SA(b, h) (((b) * 2 + (h)) * HTB)
#define PG8_SB(b, h) ((4 + (b) * 2 + (h)) * HTB)
#define PG8_STAGE(bufoff, gbase, voff) do { _Pragma("unroll") for (int _i = 0; _i < 2; ++_i) \
        __builtin_amdgcn_global_load_lds((const unsigned*)((const char*)(gbase) + (voff)[_i]), (PG8_LAS unsigned*)(lds + (bufoff) + ldsw + _i * 8192), 16, 0, 0); } while (0)
#define PG8_LDA(dst, b, h) do { _Pragma("unroll") for (int m = 0; m < 4; ++m) _Pragma("unroll") for (int k = 0; k < 2; ++k) dst[m][k] = *(const PG8_LAS bf16x8*)(lds + PG8_SA(b, h) + aoff + m * 2048 + k * 1024); } while (0)
#define PG8_LDB(dst, b, h) do { _Pragma("unroll") for (int n = 0; n < 2; ++n) _Pragma("unroll") for (int k = 0; k < 2; ++k) dst[n][k] = *(const PG8_LAS bf16x8*)(lds + PG8_SB(b, h) + boff + n * 2048 + k * 1024); } while (0)
#define PG8_MMA(ai, bj, At, Bt) do { __builtin_amdgcn_s_setprio(1); _Pragma("unroll") for (int m = 0; m < 4; ++m) _Pragma("unroll") for (int n = 0; n < 2; ++n) _Pragma("unroll") for (int k = 0; k < 2; ++k) \
        { if constexpr (F16) acc[ai][bj][m][n] = __builtin_amdgcn_mfma_f32_16x16x32_f16(__builtin_bit_cast(f16x8, Bt[n][k]), __builtin_bit_cast(f16x8, At[m][k]), acc[ai][bj][m][n], 0, 0, 0); \
          else acc[ai][bj][m][n] = __builtin_amdgcn_mfma_f32_16x16x32_bf16(Bt[n][k], At[m][k], acc[ai][bj][m][n], 0, 0, 0); } __builtin_amdgcn_s_setprio(0); } while (0)
#define PG8_WAIT_V(n) asm volatile("s_waitcnt vmcnt(" #n ")" ::: "memory")
#define PG8_WAIT_L(n) asm volatile("s_waitcnt lgkmcnt(" #n ")" ::: "memory")
#define PG8_BAR __builtin_amdgcn_s_barrier()
#define PG8_SCHED __builtin_amdgcn_sched_barrier(0)
#define PG8_BASEA(u) ((const char*)g.A + (size_t)(u).pm * tsA)
#define PG8_BASEB(u) ((const char*)g.Bt + (size_t)((u).pm / g.pm_per_batch) * g.bstrideB * 2 + (size_t)(u).pn * tsB)
    Unit cur, nxt; int ui = 0;
    if (!S.next(0, cur)) return;
    f32x4 acc[2][2][4][2];
#pragma unroll
    for (int a = 0; a < 2; ++a)
#pragma unroll
        for (int b = 0; b < 2; ++b)
#pragma unroll
            for (int m = 0; m < 4; ++m)
#pragma unroll
                for (int n = 0; n < 2; ++n) acc[a][b][m][n] = (f32x4){0.f, 0.f, 0.f, 0.f};
    bf16x8 At[4][2], B0[2][2], B1[2][2];
    typename Epi::Pre pre;
    const char* cA = PG8_BASEA(cur); const char* cB = PG8_BASEB(cur);
    PG8_STAGE(PG8_SB(0, 0), cB, voffB); PG8_STAGE(PG8_SB(0, 1), cB + hsB, voffB); PG8_STAGE(PG8_SA(0, 0), cA, voffA); PG8_STAGE(PG8_SA(0, 1), cA + hsA, voffA);
    if (wr == 1) PG8_BAR;
    PG8_WAIT_V(2); PG8_BAR;
    PG8_STAGE(PG8_SB(1, 0), cB + kstep, voffB); PG8_STAGE(PG8_SA(1, 0), cA + kstep, voffA); PG8_STAGE(PG8_SB(1, 1), cB + hsB + kstep, voffB);
    PG8_WAIT_V(6); PG8_BAR;
    for (;;) {
        const bool has_next = S.next(ui + 1, nxt);
        const char* nA = has_next ? PG8_BASEA(nxt) : cA; const char* nB = has_next ? PG8_BASEB(nxt) : cB;
        E.prefetch(cur, wid, lds + STAGE_BYTES + 4096 + wid * 256);
        for (int t = 0; t < nt; t += 2) {
            const bool last = (t == nt - 2);
            const char* a1 = cA + (size_t)(t + 1) * kstep;
            const char* a2 = last ? nA : cA + (size_t)(t + 2) * kstep; const char* b2 = last ? nB : cB + (size_t)(t + 2) * kstep;
            const char* a3 = a2 + kstep; const char* b3 = b2 + kstep;
            PG8_LDB(B0, 0, 0); PG8_LDB(B1, 0, 1); PG8_SCHED; PG8_LDA(At, 0, 0); PG8_STAGE(PG8_SA(1, 1), a1 + hsA, voffA);
            PG8_WAIT_V(8); PG8_WAIT_L(0); PG8_BAR; PG8_MMA(0, 0, At, B0); PG8_MMA(0, 1, At, B1); PG8_BAR; PG8_SCHED;
            PG8_LDA(At, 0, 1); PG8_STAGE(PG8_SB(0, 0), b2, voffB); PG8_STAGE(PG8_SB(0, 1), b2 + hsB, voffB); PG8_STAGE(PG8_SA(0, 0), a2, voffA);
            PG8_WAIT_V(8); PG8_WAIT_L(0); PG8_BAR; PG8_MMA(1, 0, At, B0); PG8_MMA(1, 1, At, B1); PG8_BAR; PG8_SCHED;
            PG8_LDB(B0, 1, 0); PG8_LDB(B1, 1, 1); PG8_SCHED; PG8_LDA(At, 1, 0); PG8_STAGE(PG8_SA(0, 1), a2 + hsA, voffA);
            PG8_WAIT_V(8); PG8_WAIT_L(0); PG8_BAR; PG8_MMA(0, 0, At, B0); PG8_MMA(0, 1, At, B1); PG8_BAR; PG8_SCHED;
            PG8_LDA(At, 1, 1); PG8_STAGE(PG8_SB(1, 0), b3, voffB); PG8_STAGE(PG8_SB(1, 1), b3 + hsB, voffB); PG8_STAGE(PG8_SA(1, 0), a3, voffA);
            PG8_WAIT_V(8); PG8_WAIT_L(0); PG8_BAR;
            if constexpr (Epi::HAS_PRE) { if (last) E.preload(cur, wr, wc, pre); }
            PG8_MMA(1, 0, At, B0); PG8_MMA(1, 1, At, B1); PG8_BAR; PG8_SCHED;
        }
        if (wr == 0) PG8_BAR;
        { int ln; asm volatile("v_mbcnt_lo_u32_b32 %0, -1, 0\n\tv_mbcnt_hi_u32_b32 %0, -1, %0" : "=v"(ln));
          if constexpr (Epi::HAS_PRE) E(acc, cur, wr, wc, ln & 15, ln >> 4, pre); else E(acc, cur, wr, wc, ln & 15, ln >> 4); }
        if (!has_next) break;
#pragma unroll
        for (int a = 0; a < 2; ++a)
#pragma unroll
            for (int b = 0; b < 2; ++b)
#pragma unroll
                for (int m = 0; m < 4; ++m)
#pragma unroll
                    for (int n = 0; n < 2; ++n) acc[a][b][m][n] = (f32x4){0.f, 0.f, 0.f, 0.f};
        cur = nxt; cA = nA; cB = nB; ++ui;
        if (wr == 1) PG8_BAR;
    }
    PG8_WAIT_V(0);
    PG8_BAR;
#undef PG8_SA
#undef PG8_SB
#undef PG8_STAGE
#undef PG8_LDA
#undef PG8_LDB
#undef PG8_MMA
#undef PG8_WAIT_V
#undef PG8_WAIT_L
#undef PG8_BAR
#undef PG8_SCHED
#undef PG8_BASEA
#undef PG8_BASEB
}
}

namespace attn_body {
using bf16=__hip_bfloat16;
using bf16x8=__attribute__((ext_vector_type(8)))short;
using s16x4=__attribute__((ext_vector_type(4)))short;
using f32x16=__attribute__((ext_vector_type(16)))float;
using u32x4=__attribute__((ext_vector_type(4)))unsigned;
constexpr int SEQ=2048,D=64;
constexpr int QP=1536, OP=1024;
constexpr int NW=8,QBLK=32,QB=QBLK*NW,KVBLK=64,NQB=SEQ/QB;
__device__ __forceinline__ int crow(int r,int hi){return (r&3)+8*(r>>2)+4*hi;}
#define SBAR() __builtin_amdgcn_sched_barrier(0)
__device__ __forceinline__ void cmask(f32x16&p0,f32x16&p1,int jb,int qrel,int hi){
  const float NEG=-INFINITY; int kb=64*jb+4*hi;
  #pragma unroll
  for(int r=0;r<16;++r){int kv=kb+(r&3)+8*(r>>2); if(kv>qrel)p0[r]=NEG; if(kv+32>qrel)p1[r]=NEG;}
}
constexpr int NSLOT=3, SLOTB=8192, VSLOTB=16384;
constexpr int LDS_K=0, LDS_V=NSLOT*SLOTB, LDS_WS=LDS_V+NSLOT*VSLOTB, LDS_OST=LDS_WS+NW*64*4, LDS_BYTES=LDS_OST+NW*4096;
constexpr float C2=0.125f*1.4426950408889634f;
__device__ __forceinline__ void glds16(const void*gbase,unsigned voff,unsigned lds_dst){unsigned keep;
  asm volatile("s_mov_b32 %0, m0\n\ts_mov_b32 m0, %3\n\ts_nop 0\n\tglobal_load_lds_dwordx4 %1, %2\n\ts_mov_b32 m0, %0":"=&s"(keep):"v"(voff),"s"(gbase),"s"(lds_dst):"memory");}
__device__ __forceinline__ float max3f(float a,float b,float c){float r;asm("v_max3_f32 %0, %1, %2, %3":"=v"(r):"v"(a),"v"(b),"v"(c));return r;}
__device__ __forceinline__ float max2f(float a,float b){float r;asm("v_max_f32_e32 %0, %1, %2":"=v"(r):"v"(a),"v"(b));return r;}
__device__ __forceinline__ float fadd_s(float a,float b){float r;asm("v_add_f32_e32 %0, %1, %2":"=v"(r):"v"(a),"v"(b));return r;}
__device__ __forceinline__ float fsub_s(float a,float b){float r;asm("v_sub_f32_e32 %0, %1, %2":"=v"(r):"v"(a),"v"(b));return r;}
typedef float f32x2_t __attribute__((ext_vector_type(2))); typedef __bf16 bf16x2_t __attribute__((ext_vector_type(2)));
__device__ __forceinline__ unsigned cvtpk_s(float lo,float hi){f32x2_t v={lo,hi};bf16x2_t b=__builtin_convertvector(v,bf16x2_t);return __builtin_bit_cast(unsigned,b);}
#define WAIT_BAR(N) asm volatile("s_waitcnt vmcnt(" #N ") lgkmcnt(0)\n\ts_barrier":::"memory")

__device__ __forceinline__ void qkt(f32x16&p0,f32x16&p1,const char*Kslot,const bf16x8*qr,const f32x16&negm,int r32,int hi){
  const char*kb=Kslot+hi*1024+r32*16;
  #pragma unroll
  for(int d0=0;d0<4;++d0){
    const bf16x8 b0=*reinterpret_cast<const bf16x8*>(kb+d0*2048);
    const bf16x8 b1=*reinterpret_cast<const bf16x8*>(kb+d0*2048+512);
    if(d0==0){p0=__builtin_amdgcn_mfma_f32_32x32x16_bf16(b0,qr[0],negm,0,0,0);p1=__builtin_amdgcn_mfma_f32_32x32x16_bf16(b1,qr[0],negm,0,0,0);}
    else{p0=__builtin_amdgcn_mfma_f32_32x32x16_bf16(b0,qr[d0],p0,0,0,0);p1=__builtin_amdgcn_mfma_f32_32x32x16_bf16(b1,qr[d0],p1,0,0,0);}}
}
typedef __attribute__((address_space(3))) const char* lds_cptr;
typedef short v4i16_t __attribute__((ext_vector_type(4)));
__device__ __forceinline__ void kload8(bf16x8*kf,lds_cptr kp){
  kf[0]=*(const __attribute__((address_space(3))) bf16x8*)(kp);      kf[1]=*(const __attribute__((address_space(3))) bf16x8*)(kp+512);
  kf[2]=*(const __attribute__((address_space(3))) bf16x8*)(kp+2048); kf[3]=*(const __attribute__((address_space(3))) bf16x8*)(kp+2560);
  kf[4]=*(const __attribute__((address_space(3))) bf16x8*)(kp+4096); kf[5]=*(const __attribute__((address_space(3))) bf16x8*)(kp+4608);
  kf[6]=*(const __attribute__((address_space(3))) bf16x8*)(kp+6144); kf[7]=*(const __attribute__((address_space(3))) bf16x8*)(kp+6656);
}
__device__ __forceinline__ void kload2(bf16x8*kf,lds_cptr kp,int j){ kf[2*j]=*(const __attribute__((address_space(3))) bf16x8*)(kp+j*2048); kf[2*j+1]=*(const __attribute__((address_space(3))) bf16x8*)(kp+j*2048+512); }
__device__ __forceinline__ s16x4 vtr(lds_cptr p){ return __builtin_bit_cast(s16x4,__builtin_amdgcn_ds_read_tr16_b64_v4i16((__attribute__((address_space(3))) v4i16_t*)p)); }
__device__ __forceinline__ float rowmax(const f32x16&p0,const f32x16&p1){
  float a=max3f(p0[0],p0[1],p1[0]),b=max3f(p0[2],p0[3],p1[1]);a=max3f(a,p1[2],p1[3]);
  #pragma unroll
  for(int r=4;r<16;r+=4){a=max3f(a,p0[r],p0[r+1]);b=max3f(b,p0[r+2],p0[r+3]);a=max3f(a,p1[r],p1[r+1]);b=max3f(b,p1[r+2],p1[r+3]);}
  const float m=max2f(a,b);
  auto rr=__builtin_amdgcn_permlane32_swap(__float_as_uint(m),__float_as_uint(m),false,false);
  return max2f(__uint_as_float(rr[0]),__uint_as_float(rr[1]));
}
__device__ __forceinline__ void pv(f32x16*o,int vb,bf16x8 pa0,bf16x8 pa1,bf16x8 pa2,bf16x8 pa3){
  #pragma unroll
  for(int d0=0;d0<2;++d0){s16x4 lo[4],hi[4];
    #pragma unroll
    for(int ks=0;ks<4;++ks){
      asm volatile("ds_read_b64_tr_b16 %0,%1 offset:%c2":"=&v"(lo[ks]):"v"(vb),"i"(d0*4096+ks*1024):"memory");
      asm volatile("ds_read_b64_tr_b16 %0,%1 offset:%c2":"=&v"(hi[ks]):"v"(vb),"i"(d0*4096+ks*1024+512):"memory");}
    asm volatile("s_waitcnt lgkmcnt(0)":::"memory");SBAR();
    #define PK(k) (bf16x8){lo[k][0],lo[k][1],lo[k][2],lo[k][3],hi[k][0],hi[k][1],hi[k][2],hi[k][3]}
    o[d0]=__builtin_amdgcn_mfma_f32_32x32x16_bf16(pa0,PK(0),o[d0],0,0,0);
    o[d0]=__builtin_amdgcn_mfma_f32_32x32x16_bf16(pa1,PK(1),o[d0],0,0,0);
    o[d0]=__builtin_amdgcn_mfma_f32_32x32x16_bf16(pa2,PK(2),o[d0],0,0,0);
    o[d0]=__builtin_amdgcn_mfma_f32_32x32x16_bf16(pa3,PK(3),o[d0],0,0,0);
    #undef PK
  }
}
#define ATTN_STORE16(p,v) (*(u32x4*)(p)=(v))
template<int THRL> __device__ __forceinline__ void attn_unit(int b,int qb,const bf16*Qh,const bf16*__restrict__ Kh0,const bf16*__restrict__ Vh0,bf16*Oh,char*shm,int tid){
  asm volatile("":"+v"(tid)); const int lane=tid&63,r32=lane&31,hi=lane>>5; const int wid=__builtin_amdgcn_readfirstlane(tid>>6);
  const long rowbase=(long)b*SEQ; const int q0=qb*QB;
  const bf16*Qw=Qh+(rowbase+q0+wid*QBLK)*QP;
  const bf16*Kh=Kh0+rowbase*QP,*Vh=Vh0+rowbase*QP;
  const unsigned lds0=(unsigned)(uintptr_t)shm;
  float*wsf=(float*)(shm+LDS_WS)+wid*64;
  const unsigned koff=(unsigned)(lane*QP+wid*8)*2u;
  const unsigned voff=(unsigned)((16*(wid&3)+(lane>>2))*QP+(wid>>2)*32+(lane&3)*8)*2u;
  const unsigned kdst=lds0+LDS_K+wid*1024, vdst=lds0+LDS_V+wid*1024;
  #define DMA_K(t,slot) glds16(Kh+(long)(t)*KVBLK*QP,koff,(unsigned)__builtin_amdgcn_readfirstlane(kdst+(slot)))
  #define DMA_V(t,slot) do{ glds16(Vh+(long)(t)*KVBLK*QP,voff,(unsigned)__builtin_amdgcn_readfirstlane(vdst+2*(slot))); glds16(Vh+64+(long)(t)*KVBLK*QP,voff,(unsigned)__builtin_amdgcn_readfirstlane(vdst+2*(slot)+8192)); }while(0)
  const int vb0=(int)(lds0+LDS_V)+((lane>>4)&1)*32+(lane&3)*8+(4*hi+((lane&15)>>2))*64;
  const char*Kbase=shm+LDS_K; bf16x8 kf[8];
  const lds_cptr shm3=(lds_cptr)shm; const lds_cptr kp0=shm3+LDS_K+hi*1024+r32*16; const lds_cptr vp0=shm3+LDS_V+((lane>>4)&1)*32+(lane&3)*8+(4*hi+((lane&15)>>2))*64;
  const int NT=(q0+QB)/KVBLK;
  DMA_K(0,0);DMA_V(0,0);DMA_K(1,SLOTB);
  bf16x8 qr[4];
  #pragma unroll
  for(int d0=0;d0<4;++d0)qr[d0]=*reinterpret_cast<const bf16x8*>(&Qw[(long)r32*QP+d0*16+hi*8]);
  float mhat=0.f,l_reg=0.f;f32x16 o[4];o[0]=f32x16{};o[1]=f32x16{};o[2]=f32x16{};o[3]=f32x16{};const f32x16 negm=f32x16{};
  const int qrel=wid*QBLK+r32;
  #define CMASK(P0,P1,t) do{int jb_=(t)-(NT-4); if(jb_>=0)cmask(P0,P1,jb_,qrel,hi);}while(0)
  bool resc=false;
  #define START(P0,P1) do{ const float rm=rowmax(P0,P1); resc=false; \
    { const float dl=rm; mhat=fadd_s(mhat,dl); \
      _Pragma("unroll") for(int r=0;r<16;++r){P0[r]=fsub_s(P0[r],dl);P1[r]=fsub_s(P1[r],dl);} \
      } \
    _Pragma("unroll") for(int r=0;r<16;++r)P0[r]=__builtin_amdgcn_exp2f(P0[r]); }while(0)
  #define RESC() do{ if(resc){ asm volatile("s_waitcnt lgkmcnt(0)":::"memory"); \
      _Pragma("unroll") for(int d_=0;d_<4;++d_) _Pragma("unroll") for(int r=0;r<16;++r)o[d_][r]*=wsf[crow(r,hi)]; } }while(0)
  f32x16 pA0,pA1,pB0,pB1;
  int sl_prev=0,sl_cur=0,sl_next=SLOTB;
  #define ROT() do{sl_prev=sl_cur;sl_cur=sl_next;sl_next=(sl_next==(NSLOT-1)*SLOTB)?0:sl_next+SLOTB;}while(0)
  DMA_K(2,2*SLOTB);
  WAIT_BAR(3);
  qkt(pA0,pA1,Kbase,qr,negm,r32,hi);asm volatile("s_nop 15\n\ts_nop 7":"+v"(pA0),"+v"(pA1));CMASK(pA0,pA1,0);
  START(pA0,pA1);
  _Pragma("unroll") for(int r=0;r<16;++r)pA1[r]=__builtin_amdgcn_exp2f(pA1[r]);
  WAIT_BAR(0);
  DMA_K(3,0);DMA_V(1,SLOTB);
  ROT();
  kload8(kf,kp0+sl_cur);
  WAIT_BAR(3);
  s16x4 vlo[8],vhi[8]; u32x4 pw0,pw1,pw2,pw3;
  #define PKW(P,B) cvtpk_s(P[B],P[B+1])
  #define PAF(k) __builtin_bit_cast(bf16x8,pw##k)
  #define VFR(i) (bf16x8){vlo[i][0],vlo[i][1],vlo[i][2],vlo[i][3],vhi[i][0],vhi[i][1],vhi[i][2],vhi[i][3]}
  #define PIN(x) asm volatile("":"+v"(x))
  #define MX3(a,b,c) __builtin_fmaxf(__builtin_fmaxf((a),(b)),(c))
  #define GAPA(MF,A0,A1,A2,A3,W0,W1,PW) do{ MF; sacc+=A0; sacc+=A1; sacc+=A2; sacc+=A3; PIN(sacc); W0; W1; PIN(PW); SBAR(); }while(0)
  #define EX(v) __builtin_amdgcn_exp2f(v)
  #define GAPB(MF,X,B) do{ MF; X[B]=EX(X[B]); X[B+1]=EX(X[B+1]); X[B+2]=EX(X[B+2]); X[B+3]=EX(X[B+3]); PIN(X); SBAR(); }while(0)
  #define VRD(i) do{ vlo[i]=vtr(vp_+(((i)>>2)*4096+((i)&3)*1024)); vhi[i]=vtr(vp_+(((i)>>2)*4096+((i)&3)*1024+512)); }while(0)
  #define KRD(G,j) do{ if(G){ kload2(kf,kp0+sl_next,j); SBAR(); } }while(0)
  #define STEP(C0,C1,P0,P1,t,GK,GV,GL) do{ SBAR(); \
    const lds_cptr vp_=vp0+2*sl_prev; \
    VRD(0); SBAR(); float sacc=(P0[0]+P0[1]); \
    GAPA(C0=__builtin_amdgcn_mfma_f32_32x32x16_bf16(kf[0],qr[0],negm,0,0,0), P0[2],P0[3],P0[4],P0[5],     pw0[0]=PKW(P0,0), pw0[1]=PKW(P0,2), pw0); \
    VRD(4); SBAR(); GAPA(C1=__builtin_amdgcn_mfma_f32_32x32x16_bf16(kf[1],qr[0],negm,0,0,0), P0[6],P0[7],P0[8],P0[9],     pw0[2]=PKW(P0,4), pw0[3]=PKW(P0,6), pw0); \
    VRD(1); SBAR(); GAPA(C0=__builtin_amdgcn_mfma_f32_32x32x16_bf16(kf[2],qr[1],C0,0,0,0),   P0[10],P0[11],P0[12],P0[13], pw1[0]=PKW(P0,8), pw1[1]=PKW(P0,10), pw1); \
    VRD(5); SBAR(); GAPA(C1=__builtin_amdgcn_mfma_f32_32x32x16_bf16(kf[3],qr[1],C1,0,0,0),   P0[14],P0[15],P1[0],P1[1],   pw1[2]=PKW(P0,12),pw1[3]=PKW(P0,14), pw1); \
    VRD(2); SBAR(); GAPA(C0=__builtin_amdgcn_mfma_f32_32x32x16_bf16(kf[4],qr[2],C0,0,0,0),   P1[2],P1[3],P1[4],P1[5],     pw2[0]=PKW(P1,0), pw2[1]=PKW(P1,2), pw2); \
    VRD(6); SBAR(); GAPA(C1=__builtin_amdgcn_mfma_f32_32x32x16_bf16(kf[5],qr[2],C1,0,0,0),   P1[6],P1[7],P1[8],P1[9],     pw2[2]=PKW(P1,4), pw2[3]=PKW(P1,6), pw2); \
    VRD(3); SBAR(); GAPA(C0=__builtin_amdgcn_mfma_f32_32x32x16_bf16(kf[6],qr[3],C0,0,0,0),   P1[10],P1[11],P1[12],P1[13], pw3[0]=PKW(P1,8), pw3[1]=PKW(P1,10), pw3); \
    VRD(7); SBAR(); GAPA(C1=__builtin_amdgcn_mfma_f32_32x32x16_bf16(kf[7],qr[3],C1,0,0,0),   P1[14],P1[15],0.f,0.f,       pw3[2]=PKW(P1,12),pw3[3]=PKW(P1,14), pw3); \
    l_reg+=sacc; \
    if(GK){DMA_K((t)+3,sl_cur);} if(GV){DMA_V((t)+1,sl_next);} \
    _Pragma("unroll") for(int r=0;r<16;++r){C0[r]-=mhat;C1[r]-=mhat;} \
    CMASK(C0,C1,t); \
    { float a=MX3(C0[0],C0[1],C1[0]),b=MX3(C0[2],C0[3],C1[1]); a=MX3(a,C1[2],C1[3]); \
      _Pragma("unroll") for(int r=4;r<16;r+=4){a=MX3(a,C0[r],C0[r+1]);b=MX3(b,C0[r+2],C0[r+3]);a=MX3(a,C1[r],C1[r+1]);b=MX3(b,C1[r+2],C1[r+3]);} \
      float rm=__builtin_fmaxf(a,b); { auto rr=__builtin_amdgcn_permlane32_swap(__float_as_uint(rm),__float_as_uint(rm),false,false); rm=__builtin_fmaxf(__uint_as_float(rr[0]),__uint_as_float(rr[1])); } \
      resc=false; \
      if(__builtin_expect(__any(rm>(float)THRL),0)){ const float dl=__builtin_fmaxf(rm,0.f); mhat+=dl; \
        _Pragma("unroll") for(int r=0;r<16;++r){C0[r]-=dl;C1[r]-=dl;} \
        const float f=__builtin_amdgcn_exp2f(-dl); l_reg*=f; if(hi==0)wsf[r32]=f; resc=true; } } \
    SBAR(); \
    GAPB(o[0]=__builtin_amdgcn_mfma_f32_32x32x16_bf16(PAF(0),VFR(0),o[0],0,0,0), C0,0); \
    GAPB(o[1]=__builtin_amdgcn_mfma_f32_32x32x16_bf16(PAF(0),VFR(4),o[1],0,0,0), C0,4); \
    KRD(GL,0); GAPB(o[0]=__builtin_amdgcn_mfma_f32_32x32x16_bf16(PAF(1),VFR(1),o[0],0,0,0), C0,8); \
    KRD(GL,1); GAPB(o[1]=__builtin_amdgcn_mfma_f32_32x32x16_bf16(PAF(1),VFR(5),o[1],0,0,0), C0,12); \
    KRD(GL,2); GAPB(o[0]=__builtin_amdgcn_mfma_f32_32x32x16_bf16(PAF(2),VFR(2),o[0],0,0,0), C1,0); \
    KRD(GL,3); GAPB(o[1]=__builtin_amdgcn_mfma_f32_32x32x16_bf16(PAF(2),VFR(6),o[1],0,0,0), C1,4); \
    GAPB(o[0]=__builtin_amdgcn_mfma_f32_32x32x16_bf16(PAF(3),VFR(3),o[0],0,0,0), C1,8); \
    GAPB(o[1]=__builtin_amdgcn_mfma_f32_32x32x16_bf16(PAF(3),VFR(7),o[1],0,0,0), C1,12); \
    { const lds_cptr vq_=vp_+8192; \
      _Pragma("unroll") for(int i_=0;i_<8;++i_){ vlo[i_]=vtr(vq_+((i_>>2)*4096+(i_&3)*1024)); vhi[i_]=vtr(vq_+((i_>>2)*4096+(i_&3)*1024+512)); } SBAR(); \
      o[2]=__builtin_amdgcn_mfma_f32_32x32x16_bf16(PAF(0),VFR(0),o[2],0,0,0); o[3]=__builtin_amdgcn_mfma_f32_32x32x16_bf16(PAF(0),VFR(4),o[3],0,0,0); \
      o[2]=__builtin_amdgcn_mfma_f32_32x32x16_bf16(PAF(1),VFR(1),o[2],0,0,0); o[3]=__builtin_amdgcn_mfma_f32_32x32x16_bf16(PAF(1),VFR(5),o[3],0,0,0); \
      o[2]=__builtin_amdgcn_mfma_f32_32x32x16_bf16(PAF(2),VFR(2),o[2],0,0,0); o[3]=__builtin_amdgcn_mfma_f32_32x32x16_bf16(PAF(2),VFR(6),o[3],0,0,0); \
      o[2]=__builtin_amdgcn_mfma_f32_32x32x16_bf16(PAF(3),VFR(3),o[2],0,0,0); o[3]=__builtin_amdgcn_mfma_f32_32x32x16_bf16(PAF(3),VFR(7),o[3],0,0,0); SBAR(); } \
    }while(0)
  int t=1;
  #undef CMASK
  #define CMASK(P0,P1,t) do{}while(0)
  for(;t+5<NT;t+=2){
    STEP(pB0,pB1,pA0,pA1,t,true,true,true);     WAIT_BAR(3); RESC(); ROT();
    STEP(pA0,pA1,pB0,pB1,t+1,true,true,true);   WAIT_BAR(3); RESC(); ROT();
  }
  #undef CMASK
  #define CMASK(P0,P1,t) do{int jb_=(t)-(NT-4); if(jb_>=0)cmask(P0,P1,jb_,qrel,hi);}while(0)
  #define ENDW(tt) do{ if((tt)+3<NT){WAIT_BAR(3);} else if((tt)+2<NT){WAIT_BAR(2);} else {WAIT_BAR(0);} }while(0)
  for(;t+1<NT;t+=2){
    STEP(pB0,pB1,pA0,pA1,t,(t+3<NT),(t+1<NT),(t+1<NT));       ENDW(t);   RESC(); ROT();
    STEP(pA0,pA1,pB0,pB1,t+1,(t+4<NT),(t+2<NT),(t+2<NT));     ENDW(t+1); RESC(); ROT();
  }
  STEP(pB0,pB1,pA0,pA1,NT-1,false,false,false); RESC();
  { float sacc=pB0[0]+pB0[1]; _Pragma("unroll") for(int r=2;r<16;++r)sacc+=pB0[r]; _Pragma("unroll") for(int r=0;r<16;++r)sacc+=pB1[r]; l_reg+=sacc;
    pw0=(u32x4){PKW(pB0,0),PKW(pB0,2),PKW(pB0,4),PKW(pB0,6)};pw1=(u32x4){PKW(pB0,8),PKW(pB0,10),PKW(pB0,12),PKW(pB0,14)};pw2=(u32x4){PKW(pB1,0),PKW(pB1,2),PKW(pB1,4),PKW(pB1,6)};pw3=(u32x4){PKW(pB1,8),PKW(pB1,10),PKW(pB1,12),PKW(pB1,14)};
    SBAR(); pv(o,vb0+2*sl_cur,PAF(0),PAF(1),PAF(2),PAF(3)); pv(o+2,vb0+2*sl_cur+8192,PAF(0),PAF(1),PAF(2),PAF(3)); }
  #undef PKW
  #undef PAF
  #undef VFR
  #undef PIN
  #undef MX3
  #undef GAPA
  #undef GAPB
  #undef EX
  #undef VRD
  #undef KRD
  #undef STEP
  #undef ENDW
  {auto rr=__builtin_amdgcn_permlane32_swap(__float_as_uint(l_reg),__float_as_uint(l_reg),false,false);l_reg=__uint_as_float(rr[0])+__uint_as_float(rr[1]);}
  if(hi==0)wsf[32+r32]=l_reg;asm volatile("s_waitcnt lgkmcnt(0)":::"memory");
  float rli[16];
  #pragma unroll
  for(int r=0;r<16;++r)rli[r]=__builtin_amdgcn_rcpf(wsf[32+crow(r,hi)]);
  bf16*Ow=Oh+(rowbase+q0+wid*QBLK)*OP;
  { bf16*stg=(bf16*)(shm+LDS_OST)+wid*2048;
    #pragma unroll
    for(int ps_=0;ps_<2;++ps_){
      #pragma unroll
      for(int r=0;r<16;++r){const int orow=crow(r,hi);
        #pragma unroll
        for(int d0=0;d0<2;++d0)stg[orow*64+d0*32+r32]=__float2bfloat16(o[2*ps_+d0][r]*rli[r]);}
      asm volatile("s_waitcnt lgkmcnt(0)":::"memory");
      #pragma unroll
      for(int i=0;i<4;++i){const int row=i*8+(lane>>3),ch=lane&7; const u32x4 v=*(const u32x4*)(stg+row*64+ch*8); ATTN_STORE16(Ow+(long)row*OP+ps_*64+ch*8,v);}
      asm volatile("s_waitcnt lgkmcnt(0)":::"memory"); } }
  asm volatile("s_waitcnt lgkmcnt(0)\n\ts_barrier":::"memory");
  #undef DMA_K
  #undef DMA_V
  #undef CMASK
  #undef START
  #undef RESC
  #undef ROT
}
constexpr int ATTN_LDS_BYTES=LDS_BYTES;
#undef SBAR
#undef WAIT_BAR
}

constexpr int NWAVES = 8;
constexpr int NB = 16, SEQ = 2048, DM = 1024, DEPTH = 4, M = NB * SEQ;
constexpr int DSSM = 512, NG = 32, NP = 64, NCH = 16, TCH = 32, NCHUNK = SEQ / TCH;
constexpr int DFF = 2816, INCOLS = 2048;
constexpr int KY = 640;
constexpr float LN_EPS = 1e-5f, RMS_EPS = 1e-5f;
constexpr float ALPHA = 1.681792830507429f;

constexpr size_t MiB = 1u << 20;
constexpr size_t WS_CTL = 0, WS_STATS = 1 * MiB, CTL_ZERO_BYTES = 3 * MiB;
constexpr size_t WS_MOD = 3 * MiB;
constexpr size_t WS_ONES = 4 * MiB + 512 * 1024;
constexpr size_t WS_COS = 5 * MiB, WS_SIN = 6 * MiB;
constexpr size_t WS_CSBW = 7 * MiB;
constexpr size_t WS_GP = 11 * MiB;
constexpr size_t WS_GPINV = 11 * MiB + 512 * 1024;
constexpr size_t WS_MROWS = 12 * MiB;
constexpr size_t WS_W = 16 * MiB;
constexpr size_t W_IN = 0, W_GLU = W_IN + (size_t)2048 * 1024 * 2, W_OUT = W_GLU + (size_t)512 * 512 * 2, W_GU = W_OUT + (size_t)1024 * 1024 * 2,
                 W_DN = W_GU + (size_t)5632 * 1024 * 2, W_LAYER = W_DN + (size_t)1024 * 2816 * 2;
static_assert(W_LAYER == 23 * MiB, "weights per layer");
constexpr size_t WS_SSM = WS_W + 4 * W_LAYER;
constexpr size_t SSM_MF = 0, SSM_E = (size_t)32 * 512 * 640 * 2, SSM_LAYER = SSM_E + (size_t)32 * 128 * 512 * 2;
static_assert(SSM_LAYER == 24 * MiB, "ssm tables per layer");
constexpr size_t WS_H = WS_SSM + 4 * SSM_LAYER + 1 * MiB;
constexpr size_t WS_U = WS_H + 64 * MiB;
constexpr size_t WS_QKV = WS_U + 40 * MiB;
constexpr size_t WS_CAT = WS_QKV;
constexpr size_t WS_YACT = WS_QKV + 64 * MiB;
constexpr size_t WS_O2 = WS_QKV + 96 * MiB;
constexpr size_t WS_S = WS_O2 + 64 * MiB;
constexpr size_t WS_HDN = WS_QKV;
constexpr size_t WS_END = WS_S + 16 * MiB;
static_assert(WS_HDN + (size_t)M * DFF * 2 <= WS_END && WS_END <= 512 * MiB, "ws map");

constexpr int REP_A = 1, REP_B = 1, REP_C = 1, REP_D = 1, REP_F = 1;
constexpr int RING_BYTES = 131072, MISC_OFF = RING_BYTES + 320, LDS_BYTES = 147456;

#define GAS __attribute__((address_space(1)))
#define LAS __attribute__((address_space(3)))
typedef unsigned short bf16;
typedef unsigned v4u __attribute__((ext_vector_type(4)));
typedef unsigned v2u __attribute__((ext_vector_type(2)));
typedef float f32x4 __attribute__((ext_vector_type(4)));
#define LDS_WAIT() asm volatile("s_waitcnt lgkmcnt(0)" ::: "memory")
__device__ __forceinline__ float shx(float v, int mask, int lane) { return __builtin_bit_cast(float, __builtin_amdgcn_ds_bpermute((lane ^ mask) << 2, __builtin_bit_cast(int, v))); }
__device__ __forceinline__ unsigned f2bf(float f) { unsigned u = __builtin_bit_cast(unsigned, f); return (u + 0x7fffu + ((u >> 16) & 1u)) >> 16; }
__device__ __forceinline__ unsigned pk2(float lo, float hi) { return pg8::cvt_pk_bf16(lo, hi); }
typedef _Float16 h2_t __attribute__((ext_vector_type(2))); typedef float f2_t __attribute__((ext_vector_type(2)));
__device__ __forceinline__ unsigned pkh2(float lo, float hi) { const f2_t v = {lo, hi}; const h2_t h = __builtin_convertvector(v, h2_t); return __builtin_bit_cast(unsigned, h); }
__device__ __forceinline__ float hlo(unsigned w) { return (float)__builtin_bit_cast(h2_t, w)[0]; }
__device__ __forceinline__ float hhi(unsigned w) { return (float)__builtin_bit_cast(h2_t, w)[1]; }
__device__ __forceinline__ float bflo(unsigned w) { return __builtin_bit_cast(float, w << 16); }
__device__ __forceinline__ float bfhi(unsigned w) { return __builtin_bit_cast(float, w & 0xffff0000u); }

#define XB_TMO      128
#define XB_XCNT(j)  (256  + 64 * (j))
#define XB_XSUB(j)  (1280 + 64 * (j))
#define XB_XGEN(j)  (2304 + 64 * (j))
#define XB_TOP      3328
#define XB_TOPGEN   3392
#define XCD_BAR_WORDS 3456
#define XB_SPIN_CAP (1u << 20)
__device__ __forceinline__ unsigned xb_ld(unsigned* p)              { return __hip_atomic_load(p, __ATOMIC_RELAXED, __HIP_MEMORY_SCOPE_AGENT); }
__device__ __forceinline__ unsigned xb_add(unsigned* p, unsigned v) { return __hip_atomic_fetch_add(p, v, __ATOMIC_RELAXED, __HIP_MEMORY_SCOPE_AGENT); }
__device__ __forceinline__ unsigned xb_xcc_id() { return (unsigned)__builtin_amdgcn_s_getreg((3 << 11) | 20) & 0xFu; }
#define XB_SPIN(cond, bar) do { unsigned _sp = 0; while (cond) { __builtin_amdgcn_s_sleep(1); \
    if ((++_sp & 255u) == 0u) { if (xb_ld(&(bar)[XB_TMO])) break; if (_sp > XB_SPIN_CAP) { atomicAdd(&(bar)[XB_TMO], 1u); break; } } } } while (0)
struct XcdBarrier { unsigned* bar; unsigned x; volatile LAS unsigned* st; };
__device__ __forceinline__ int lane_fresh() { int l; asm volatile("v_mbcnt_lo_u32_b32 %0, -1, 0\n\tv_mbcnt_hi_u32_b32 %0, -1, %0" : "=v"(l)); return l; }
__device__ __forceinline__ bool xb_leader(int wave_s) { return wave_s == 0 && lane_fresh() == 0; }
__device__ __forceinline__ XcdBarrier xcd_barrier_post(unsigned* bar, volatile LAS unsigned* st, int wave_s) {
    XcdBarrier b; b.bar = bar; b.x = xb_xcc_id(); b.st = st;
    if (xb_leader(wave_s)) (void)xb_add(&bar[XB_XCNT(b.x)], 1u);
    return b;
}
__device__ __forceinline__ void xcd_barrier_complete(unsigned* bar, unsigned x, unsigned& nloc, unsigned& nx) {
    const unsigned G = gridDim.x * gridDim.y * gridDim.z;
    unsigned sum, cnt, mine, sp = 0u;
    for (;;) {
        sum = 0u; cnt = 0u; mine = 0u;
#pragma unroll
        for (unsigned j = 0; j < 16; ++j) { const unsigned c = xb_ld(&bar[XB_XCNT(j)]); sum += c; cnt += (c > 0u) ? 1u : 0u; mine = (j == x) ? c : mine; }
        if (sum == G) break;
        __builtin_amdgcn_s_sleep(1);
        if ((++sp & 255u) == 0u) { if (xb_ld(&bar[XB_TMO])) break; if (sp > XB_SPIN_CAP) { atomicAdd(&bar[XB_TMO], 1u); break; } }
    }
    nloc = mine > 0u ? mine : 1u; nx = cnt > 0u ? cnt : 1u;
}
__device__ __forceinline__ void xcd_barrier(const XcdBarrier& b, int wave_s) {
    asm volatile("s_waitcnt vmcnt(0)" ::: "memory");
    __syncthreads();
    if (xb_leader(wave_s)) {
        unsigned* bar = b.bar;
        __builtin_amdgcn_s_waitcnt(0);
        unsigned nloc = b.st[0], nx = b.st[1];
        if (nloc == 0u) { xcd_barrier_complete(bar, b.x, nloc, nx); b.st[0] = nloc; b.st[1] = nx; }
        const unsigned old = xb_add(&bar[XB_XSUB(b.x)], 1u);
        const unsigned gen = old / nloc;
        if (old + 1u == (gen + 1u) * nloc) {
            __builtin_amdgcn_fence(__ATOMIC_RELEASE, "agent");
            asm volatile("s_waitcnt vmcnt(0)" ::: "memory");
            const unsigned og = xb_add(&bar[XB_TOP], 1u);
            const unsigned tg = og / nx;
            if (og + 1u == (tg + 1u) * nx) xb_add(&bar[XB_TOPGEN], 1u);
            else XB_SPIN(xb_ld(&bar[XB_TOPGEN]) == tg, bar);
            __builtin_amdgcn_fence(__ATOMIC_ACQUIRE, "agent");
            xb_add(&bar[XB_XGEN(b.x)], 1u);
            asm volatile("s_waitcnt vmcnt(0)" ::: "memory");
        } else {
            XB_SPIN(xb_ld(&bar[XB_XGEN(b.x)]) == gen, bar);
            __builtin_amdgcn_fence(__ATOMIC_ACQUIRE, "agent");
            asm volatile("s_waitcnt vmcnt(0)" ::: "memory");
        }
    }
    __syncthreads();
}

using pg8::Unit; using pg8::bf16_t; using pg8::u32x4; using pg8::pack8; using pg8::sigm;
constexpr float LN_EPS_C = 1e-5f;

struct FixPre { float2 sv[2][4]; f32x4 cv[2], bv[2]; };
__device__ __forceinline__ void fix_preload(FixPre& P, const float* st, const float* cs_b, int pm, int wr, int colt_nofq) {
    const int ln = lane_fresh(), fr = ln & 15, fq = ln >> 4; const int row0 = pm * 256 + wr * 64 + fr; const float* csb = cs_b + colt_nofq + 8 * fq;
#pragma unroll
    for (int ai = 0; ai < 2; ++ai)
#pragma unroll
        for (int m = 0; m < 4; ++m) P.sv[ai][m] = *(const float2*)((const char*)st + 8u * (unsigned)(row0 + ai * 128 + m * 16));
#pragma unroll
    for (int n = 0; n < 2; ++n) { P.cv[n] = *(const f32x4*)(csb + 4 * n); P.bv[n] = *(const f32x4*)(csb + 16 * 7680 + 4 * n); }
}
__device__ __forceinline__ void fixup(f32x4 (&acc)[2][2][4][2], const FixPre& P, bool use, const float* csb) {
    float mu[2][4], rs[2][4];
    f32x4 cv1[2], bv1[2];
#pragma unroll
    for (int n = 0; n < 2; ++n) { cv1[n] = *(const f32x4*)(csb + 128 + 4 * n); bv1[n] = *(const f32x4*)(csb + 16 * 7680 + 128 + 4 * n); }
#pragma unroll
    for (int ai = 0; ai < 2; ++ai)
#pragma unroll
        for (int m = 0; m < 4; ++m) { const float mm = P.sv[ai][m].x * (1.f / 1024.f), rr = rsqrtf(P.sv[ai][m].y * (1.f / 1024.f) - mm * mm + LN_EPS_C); mu[ai][m] = use ? mm : 0.f; rs[ai][m] = use ? rr : 1.f; }
#pragma unroll
    for (int bj = 0; bj < 2; ++bj)
#pragma unroll
        for (int n = 0; n < 2; ++n) { const f32x4 cv = bj == 0 ? P.cv[n] : cv1[n], bv = bj == 0 ? P.bv[n] : bv1[n];
#pragma unroll
            for (int ai = 0; ai < 2; ++ai)
#pragma unroll
                for (int m = 0; m < 4; ++m) acc[ai][bj][m][n] = (acc[ai][bj][m][n] - cv * mu[ai][m]) * rs[ai][m] + bv; }
}
struct EpiInProj {
    static constexpr bool PERM = true;
    static constexpr bool HAS_PRE = true; typedef FixPre Pre;
    __device__ __forceinline__ void preload(const Unit& u, int wr, int wc, Pre& P) const { fix_preload(P, st, cs + (size_t)((u.pm * 256) >> 11) * 7680, u.pm, wr, u.pn * 256 + wc * 32); }
    __device__ __forceinline__ void prefetch(const Unit&, int, PG8_LAS unsigned char*) const {}
    bf16_t* Ug; bf16_t* QKV; const float* cosT; const float* sinT; float qscale;
    const float* st; const float* cs; int use_ln;
    __device__ __forceinline__ void operator()(f32x4 (&acc)[2][2][4][2], const Unit& u, int wr, int wc, int fr, int fq, const Pre& P) const {
        const int row0 = u.pm * 256 + wr * 64 + fr, colt = u.pn * 256 + wc * 32 + 8 * fq;
        fixup(acc, P, use_ln != 0, cs + (size_t)((u.pm * 256) >> 11) * 7680 + colt);
        if (u.pn < 2) {
#pragma unroll
            for (int ai = 0; ai < 2; ++ai)
#pragma unroll
                for (int m = 0; m < 4; ++m) { const int r = row0 + ai * 128 + m * 16, b = r >> 11, t = r & 2047, j = t >> 5, s = t & 31;
#pragma unroll
                    for (int bj = 0; bj < 2; ++bj) { const int c = colt + bj * 128, g = c >> 4, c0 = c & 15;
                        *(u32x4*)(Ug + ((size_t)(g * 1024 + b * 64 + j) * KY + s * 16 + c0)) = pack8(acc[ai][bj][m][0], acc[ai][bj][m][1]); } }
        } else {
            const bool rot = (u.pn < 6) && ((wc & 1) == 0) && (fq < 2);
            const float sc = (u.pn < 4) ? qscale : 1.f;
#pragma unroll
            for (int ai = 0; ai < 2; ++ai)
#pragma unroll
                for (int m = 0; m < 4; ++m) { const int r = row0 + ai * 128 + m * 16;
                    f32x4 cs = (f32x4){1.f, 1.f, 1.f, 1.f}, sn = (f32x4){0.f, 0.f, 0.f, 0.f};
                    if (rot) { cs = *(const f32x4*)(cosT + (size_t)r * 8 + 4 * fq); sn = *(const f32x4*)(sinT + (size_t)r * 8 + 4 * fq); }
#pragma unroll
                    for (int bj = 0; bj < 2; ++bj) { f32x4 v0 = acc[ai][bj][m][0], v1 = acc[ai][bj][m][1];
                        if (rot) { f32x4 a, b2;
                            a[0] = v0[0] * cs[0] - v0[1] * sn[0]; a[1] = v0[1] * cs[0] + v0[0] * sn[0]; a[2] = v0[2] * cs[1] - v0[3] * sn[1]; a[3] = v0[3] * cs[1] + v0[2] * sn[1];
                            b2[0] = v1[0] * cs[2] - v1[1] * sn[2]; b2[1] = v1[1] * cs[2] + v1[0] * sn[2]; b2[2] = v1[2] * cs[3] - v1[3] * sn[3]; b2[3] = v1[3] * cs[3] + v1[2] * sn[3];
                            v0 = a; v1 = b2; }
                        v0 = v0 * sc; v1 = v1 * sc;
                        *(u32x4*)(QKV + ((size_t)r * 1536 + (colt - 512) + bj * 128)) = pack8(v0, v1); } }
        }
    }
};
struct EpiSsmS {
    static constexpr bool PERM = false;
    static constexpr bool HAS_PRE = false; struct Pre {};
    __device__ __forceinline__ void prefetch(const Unit&, int, PG8_LAS unsigned char*) const {}
    float* S;
    __device__ __forceinline__ void operator()(f32x4 (&acc)[2][2][4][2], const Unit& u, int wr, int wc, int fr, int fq) const {
        const int row0 = u.pm * 256 + wr * 64 + fr, col0 = wc * 32 + 4 * fq;
#pragma unroll
        for (int ai = 0; ai < 2; ++ai)
#pragma unroll
            for (int m = 0; m < 4; ++m) { const int r = row0 + ai * 128 + m * 16;
#pragma unroll
                for (int n = 0; n < 2; ++n) *(f32x4*)(S + ((size_t)r * 128 + col0 + n * 16)) = acc[ai][0][m][n]; }
    }
};
__device__ __forceinline__ float gelu_tanh(float y) { const float x = 1.5957691216057308f * (y + 0.044715f * y * y * y); return y * sigm(x); }
struct EpiSsmY {
    static constexpr bool PERM = true;
    static constexpr bool HAS_PRE = false; struct Pre {};
    __device__ __forceinline__ void prefetch(const Unit&, int, PG8_LAS unsigned char*) const {}
    bf16_t* Y;
    __device__ __forceinline__ void operator()(f32x4 (&acc)[2][2][4][2], const Unit& u, int wr, int wc, int fr, int fq) const {
        const int row0 = u.pm * 256 + wr * 64 + fr, colt = u.pn * 256 + wc * 32 + 8 * fq;
#pragma unroll
        for (int ai = 0; ai < 2; ++ai)
#pragma unroll
            for (int m = 0; m < 4; ++m) { const int r = row0 + ai * 128 + m * 16, g = r >> 10, b = (r >> 6) & 15, j = r & 63;
#pragma unroll
                for (int bj = 0; bj < 2; ++bj) { const int c = colt + bj * 128, t = c >> 4, c0 = c & 15;
                    f32x4 v0 = acc[ai][bj][m][0], v1 = acc[ai][bj][m][1];
#pragma unroll
                    for (int e = 0; e < 4; ++e) { v0[e] = gelu_tanh(v0[e]); v1[e] = gelu_tanh(v1[e]); }
                    *(u32x4*)(Y + ((size_t)(b * 2048 + j * 32 + t) * 512 + g * 16 + c0)) = pack8(v0, v1); } }
    }
};
struct EpiGlu {
    static constexpr bool PERM = true;
    static constexpr bool HAS_PRE = false; struct Pre {};
    __device__ __forceinline__ void prefetch(const Unit&, int, PG8_LAS unsigned char*) const {}
    const bf16_t* Y; const float* bias; bf16_t* CAT;
    __device__ __forceinline__ void operator()(f32x4 (&acc)[2][2][4][2], const Unit& u, int wr, int wc, int fr, int fq) const {
        const int row0 = u.pm * 256 + wr * 64 + fr, colt = u.pn * 256 + wc * 32 + 8 * fq;
        f32x4 bv[2][2];
#pragma unroll
        for (int bj = 0; bj < 2; ++bj)
#pragma unroll
            for (int n = 0; n < 2; ++n) bv[bj][n] = *(const f32x4*)(bias + colt + bj * 128 + 4 * n);
#pragma unroll
        for (int ai = 0; ai < 2; ++ai)
#pragma unroll
            for (int m = 0; m < 4; ++m) { const int r = row0 + ai * 128 + m * 16;
#pragma unroll
                for (int bj = 0; bj < 2; ++bj) { const int c = colt + bj * 128;
                    const u32x4 yw = *(const u32x4*)(Y + ((size_t)r * 512 + c));
                    f32x4 g0 = acc[ai][bj][m][0] + bv[bj][0], g1 = acc[ai][bj][m][1] + bv[bj][1], o0, o1;
                    o0[0] = bflo(yw.x) * sigm(g0[0]); o0[1] = bfhi(yw.x) * sigm(g0[1]); o0[2] = bflo(yw.y) * sigm(g0[2]); o0[3] = bfhi(yw.y) * sigm(g0[3]);
                    o1[0] = bflo(yw.z) * sigm(g1[0]); o1[1] = bfhi(yw.z) * sigm(g1[1]); o1[2] = bflo(yw.w) * sigm(g1[2]); o1[3] = bfhi(yw.w) * sigm(g1[3]);
                    *(u32x4*)(CAT + ((size_t)r * 1024 + c)) = pack8(o0, o1); } }
    }
};
struct EpiResid {
    static constexpr bool PERM = true;
    static constexpr bool HAS_PRE = false; struct Pre {};
    __device__ __forceinline__ void prefetch(const Unit& u, int wid, PG8_LAS unsigned char* dummy) const {
        const int tid = wid * 64 + lane_fresh();
#pragma unroll
        for (int i = 0; i < 2; ++i) { const int q = tid + 512 * i, row = q >> 2, seg = q & 3;
            __builtin_amdgcn_global_load_lds((const unsigned*)(Hs + ((size_t)(u.pm * 256 + row) * 1024 + u.pn * 256 + seg * 64)), (PG8_LAS unsigned*)dummy, 4, 0, 0); }
    }
    bf16_t* Hs; const float* ginv; const float* st_in; const float* g_in; const float* b_in; const float* gate; float* st_out; const float* gp; int use_ln;
    __device__ __forceinline__ void operator()(f32x4 (&acc)[2][2][4][2], const Unit& u, int wr, int wc, int fr, int fq) const {
        const int row0 = u.pm * 256 + wr * 64 + fr, col0 = u.pn * 256 + wc * 32 + 8 * fq;
        const int b = (u.pm * 256) >> 11;
        const bool use = use_ln != 0;
        const unsigned e0 = (unsigned)row0 * 1024u + (unsigned)col0;
        char* H_c = (char*)Hs;
#define RES_LDP(P, BJ) do { _Pragma("unroll") for (int n = 0; n < 2; ++n) { const unsigned c = (unsigned)(col0 + (BJ) * 128 + 4 * n); \
            P[n][0] = *(const f32x4*)(gate + (unsigned)(b * 6144) + c); P[n][1] = *(const f32x4*)(ginv + (unsigned)(b * 1024) + c); P[n][2] = *(const f32x4*)(g_in + c); \
            P[n][3] = *(const f32x4*)(b_in + c); P[n][4] = *(const f32x4*)(gp + (unsigned)(b * 1024) + c); } } while (0)
#define RES_FIXP(P) do { _Pragma("unroll") for (int n = 0; n < 2; ++n) { P[n][0] = P[n][0] + 1.0f; \
            _Pragma("unroll") for (int e = 0; e < 4; ++e) { P[n][1][e] = use ? P[n][1][e] * P[n][2][e] : P[n][1][e]; P[n][2][e] = use ? P[n][2][e] : 0.f; P[n][3][e] = use ? P[n][3][e] : 0.f; } } } while (0)
#define RES_LDH(HV, BJ, AI) do { _Pragma("unroll") for (int m = 0; m < 4; ++m) \
            HV[AI][m] = *(const u32x4*)(H_c + 2u * (e0 + (unsigned)(((AI) * 128 + m * 16) * 1024 + (BJ) * 128))); } while (0)
#define RES_PROC(HV, P, BJ, AI) do { _Pragma("unroll") for (int m = 0; m < 4; ++m) { const u32x4 hw = HV[AI][m]; u32x4 w; \
            _Pragma("unroll") for (int n = 0; n < 2; ++n) { const unsigned w0 = n == 0 ? hw.x : hw.z, w1 = n == 0 ? hw.y : hw.w; f32x4 x; \
                x[0] = hlo(w0); x[1] = hhi(w0); x[2] = hlo(w1); x[3] = hhi(w1); \
                x = (x * P[n][1] - P[n][2] * mu[AI][m]) * rs[AI][m] + P[n][3]; \
                const f32x4 z = x * ALPHA + P[n][0] * acc[AI][BJ][m][n]; \
                ps[AI][m] += (z[0] + z[1]) + (z[2] + z[3]); pq[AI][m] += (z[0] * z[0] + z[1] * z[1]) + (z[2] * z[2] + z[3] * z[3]); \
                const f32x4 h = z * P[n][4]; const unsigned o0 = pkh2(h[0], h[1]), o1 = pkh2(h[2], h[3]); if (n == 0) { w.x = o0; w.y = o1; } else { w.z = o0; w.w = o1; } } \
            *(u32x4*)(H_c + 2u * (e0 + (unsigned)(((AI) * 128 + m * 16) * 1024 + (BJ) * 128))) = w; } } while (0)
        float2 sv[2][4]; f32x4 P0[2][5]; u32x4 hv0[2][4];
#pragma unroll
        for (int ai = 0; ai < 2; ++ai)
#pragma unroll
            for (int m = 0; m < 4; ++m) sv[ai][m] = *(const float2*)((const char*)st_in + 8u * (unsigned)(row0 + ai * 128 + m * 16));
        RES_LDP(P0, 0); RES_LDH(hv0, 0, 0);
        asm volatile("" ::: "memory");
        float mu[2][4], rs[2][4], ps[2][4], pq[2][4];
#pragma unroll
        for (int ai = 0; ai < 2; ++ai)
#pragma unroll
            for (int m = 0; m < 4; ++m) { ps[ai][m] = 0.f; pq[ai][m] = 0.f;
                const float mm = sv[ai][m].x * (1.f / 1024.f), rr = rsqrtf(sv[ai][m].y * (1.f / 1024.f) - mm * mm + LN_EPS_C); mu[ai][m] = use ? mm : 0.f; rs[ai][m] = use ? rr : 1.f; }
        RES_FIXP(P0);
        RES_PROC(hv0, P0, 0, 0);
        RES_LDH(hv0, 0, 1);
        asm volatile("" ::: "memory");
        RES_PROC(hv0, P0, 0, 1);
        f32x4 P1[2][5]; u32x4 hv1[2][4]; RES_LDP(P1, 1); RES_LDH(hv1, 1, 0); RES_LDH(hv1, 1, 1);
        asm volatile("" ::: "memory");
        RES_FIXP(P1);
        RES_PROC(hv1, P1, 1, 0); RES_PROC(hv1, P1, 1, 1);
#undef RES_LDP
#undef RES_FIXP
#undef RES_LDH
#undef RES_PROC
#pragma unroll
        for (int ai = 0; ai < 2; ++ai)
#pragma unroll
            for (int m = 0; m < 4; ++m) { float a = ps[ai][m], q = pq[ai][m];
                const int ln = lane_fresh();
                a += shx(a, 16, ln); a += shx(a, 32, ln); q += shx(q, 16, ln); q += shx(q, 32, ln);
                const int rb = u.pm * 256 + wr * 64 + (ln & 15);
                if ((ln >> 4) == 0) { float* sp = (float*)((char*)st_out + 8u * (unsigned)(rb + ai * 128 + m * 16)); unsafeAtomicAdd(sp, a); unsafeAtomicAdd(sp + 1, q); } }
    }
};
struct EpiCsBw {
    static constexpr bool PERM = false;
    static constexpr bool HAS_PRE = false; struct Pre {};
    __device__ __forceinline__ void prefetch(const Unit&, int, PG8_LAS unsigned char*) const {}
    float* out; int coff;
    __device__ __forceinline__ void operator()(f32x4 (&acc)[2][2][4][2], const Unit& u, int wr, int wc, int fr, int fq) const {
        if (wr != 0) return;
        const int col0 = coff + u.pn * 256 + wc * 32 + 4 * fq;
#pragma unroll
        for (int m = 0; m < 2; ++m)
#pragma unroll
            for (int bj = 0; bj < 2; ++bj)
#pragma unroll
                for (int n = 0; n < 2; ++n) *(f32x4*)(out + ((size_t)(u.pm * 32 + m * 16 + fr) * 7680 + col0 + bj * 128 + n * 16)) = acc[0][bj][m][n];
    }
};
struct EpiSwiGlu {
    static constexpr bool PERM = true;
    static constexpr bool HAS_PRE = true; typedef FixPre Pre;
    __device__ __forceinline__ void preload(const Unit& u, int wr, int wc, Pre& P) const { fix_preload(P, st, cs + (size_t)((u.pm * 256) >> 11) * 7680, u.pm, wr, u.pn * 256 + wc * 32); }
    __device__ __forceinline__ void prefetch(const Unit&, int, PG8_LAS unsigned char*) const {}
    bf16_t* Hd; const float* st; const float* cs;
    __device__ __forceinline__ void operator()(f32x4 (&acc)[2][2][4][2], const Unit& u, int wr, int wc, int fr, int fq, const Pre& P) const {
        const int row0 = u.pm * 256 + wr * 64 + fr, col = u.pn * 128 + wc * 32 + 8 * fq;
        fixup(acc, P, true, cs + (size_t)((u.pm * 256) >> 11) * 7680 + u.pn * 256 + wc * 32 + 8 * fq);
#pragma unroll
        for (int ai = 0; ai < 2; ++ai)
#pragma unroll
            for (int m = 0; m < 4; ++m) { const int r = row0 + ai * 128 + m * 16;
                f32x4 o0, o1;
#pragma unroll
                for (int e = 0; e < 4; ++e) { const float g0 = acc[ai][0][m][0][e], g1 = acc[ai][0][m][1][e];
                    o0[e] = g0 * sigm(g0) * acc[ai][1][m][0][e]; o1[e] = g1 * sigm(g1) * acc[ai][1][m][1][e]; }
                *(u32x4*)(Hd + ((size_t)r * DFF + col)) = pack8(o0, o1); }
    }
};

struct Args { const void* in[29]; float* out; unsigned char* ws; int ph_lo, ph_hi; };
enum { I_X = 0, I_C, I_POS, I_MODW, I_MODB, I_WIN, I_ARE, I_AIM, I_LOGSTEP, I_BRE, I_BIM, I_CRE, I_CIM, I_DSKIP, I_GLUW, I_GLUB,
       I_LQ1, I_LK1, I_LQ2, I_LK2, I_SUBLN, I_WOUT, I_LN1G, I_LN1B, I_WGATE, I_WUP, I_WDOWN, I_LN2G, I_LN2B };

__device__ __forceinline__ float wave_sum(float v, int lane) {
#pragma unroll
    for (int o = 1; o < 64; o <<= 1) v += shx(v, o, lane);
    return v;
}
__device__ __forceinline__ int map_row(int mode, int n) {
    if (mode == 1) { if (n >= 512 && n < 1536) { const int j = n & 63; if (j < 16) return (n - j) + ((j < 8) ? 2 * j : 2 * (j - 8) + 1); } return n; }
    if (mode == 2) return 256 * (n >> 7) + (n & 127);
    if (mode == 3) return 256 * (n >> 7) + 128 + (n & 127);
    return n;
}
__device__ __forceinline__ void transpose_item(const float* W, int K, int N, bf16* WT, int mode, LAS float* scr, int item, int lane, bool f16) {
    const int nblk = N / 128, kb = item / nblk, nb = item % nblk, k0 = 64 * kb, n0 = 128 * nb;
    const float* src = W + (size_t)k0 * N + n0 + lane;
    float v[2][64];
#pragma unroll
    for (int i = 0; i < 64; ++i) { v[0][i] = src[(size_t)i * N]; v[1][i] = src[(size_t)i * N + 64]; }
    const int c = lane & 7;
#pragma unroll
    for (int hh = 0; hh < 2; ++hh) {
#pragma unroll
        for (int i = 0; i < 32; ++i) scr[i * 65 + lane] = __builtin_bit_cast(float, f16 ? pkh2(v[hh][2 * i], v[hh][2 * i + 1]) : pk2(v[hh][2 * i], v[hh][2 * i + 1]));
        LDS_WAIT(); asm volatile("" ::: "memory");
#pragma unroll
        for (int j = 0; j < 8; ++j) { const int n = (lane >> 3) + 8 * j; const LAS float* s = scr + (4 * c) * 65 + n;
            v4u o; o.x = __builtin_bit_cast(unsigned, s[0]); o.y = __builtin_bit_cast(unsigned, s[65]); o.z = __builtin_bit_cast(unsigned, s[130]); o.w = __builtin_bit_cast(unsigned, s[195]);
            *(v4u*)(WT + (size_t)map_row(mode, n0 + 64 * hh + n) * K + k0 + 8 * c) = o; }
        LDS_WAIT(); asm volatile("" ::: "memory"); }
}

__device__ __forceinline__ void ssm_tables_unit(const Args& A, int l, int g, LAS float* L, bf16* MF, bf16* EE, int tid) {
    asm volatile("" : "+v"(tid)); const int lg = l * NG + g;
    LAS float* LR = L; LAS float* LI = L + 33 * 64; LAS float* BR = LI + 33 * 64; LAS float* BI = BR + 1024; LAS float* CR = BI + 1024; LAS float* CI = CR + 1024; LAS float* KT = CI + 1024;
    const float delta = expf(((const float*)A.in[I_LOGSTEP])[lg]);
    const float* are = (const float*)A.in[I_ARE] + lg * 64; const float* aim = (const float*)A.in[I_AIM] + lg * 64;
    for (int idx = tid; idx < 33 * 64; idx += 512) { const int tau = idx >> 6, p = idx & 63;
        const float lre = fminf(are[p], -1e-4f), lim = aim[p];
        const float mag = expf(lre * delta * (float)tau), ang = lim * delta * (float)tau; float s, c; sincosf(ang, &s, &c);
        LR[idx] = mag * c; LI[idx] = mag * s; }
    for (int idx = tid; idx < 1024; idx += 512) { const int p = idx >> 4, cc = idx & 15;
        const float lre = fminf(are[p], -1e-4f), lim = aim[p], x = lre * delta, y = lim * delta;
        float s, c; sincosf(y, &s, &c); const float sh = sinf(0.5f * y), ex = expf(x);
        const float nre = expm1f(x) * c - 2.f * sh * sh, nim = ex * s, den = lre * lre + lim * lim;
        const float kre = (nre * lre + nim * lim) / den, kim = (nim * lre - nre * lim) / den;
        const float bre = ((const float*)A.in[I_BRE])[(size_t)(lg * 64 + p) * 16 + cc], bim = ((const float*)A.in[I_BIM])[(size_t)(lg * 64 + p) * 16 + cc];
        BR[idx] = kre * bre - kim * bim; BI[idx] = kre * bim + kim * bre; }
    for (int idx = tid; idx < 1024; idx += 512) { CR[idx] = ((const float*)A.in[I_CRE])[(size_t)lg * 1024 + idx]; CI[idx] = ((const float*)A.in[I_CIM])[(size_t)lg * 1024 + idx]; }
    __syncthreads();
    { const int tau = tid >> 4, c = tid & 15; float a[16];
#pragma unroll
      for (int i = 0; i < 16; ++i) a[i] = 0.f;
      for (int p = 0; p < 64; ++p) { const float cr = CR[c * 64 + p], ci = CI[c * 64 + p], lr = LR[tau * 64 + p], li = LI[tau * 64 + p];
          const float gr = cr * lr - ci * li, gi = cr * li + ci * lr;
#pragma unroll
          for (int i = 0; i < 16; ++i) a[i] += gr * BR[p * 16 + i] - gi * BI[p * 16 + i]; }
      if (tau == 0) { const float d = ((const float*)A.in[I_DSKIP])[lg * 16 + c];
#pragma unroll
          for (int i = 0; i < 16; ++i) a[i] += (i == c) ? d : 0.f; }
#pragma unroll
      for (int i = 0; i < 16; ++i) KT[(tau * 16 + c) * 16 + i] = a[i]; }
    __syncthreads();
    for (int q = tid; q < 512 * 80; q += 512) { const int row = q / 80, cp = q - row * 80, t = row >> 4, c = row & 15; float v[8];
        if (cp < 64) { const int s = cp >> 1, c0 = (cp & 1) * 8;
#pragma unroll
            for (int i = 0; i < 8; ++i) v[i] = (s <= t) ? KT[((t - s) * 16 + c) * 16 + c0 + i] : 0.f;
        } else { const int pidx = (cp - 64) * 8, part = pidx >> 6, pp = pidx & 63;
#pragma unroll
            for (int i = 0; i < 8; ++i) { const int p = pp + i; const float cr = CR[c * 64 + p], ci = CI[c * 64 + p], lr = LR[(t + 1) * 64 + p], li = LI[(t + 1) * 64 + p];
                v[i] = part == 0 ? (cr * lr - ci * li) : -(cr * li + ci * lr); } }
        v4u o; o.x = pk2(v[0], v[1]); o.y = pk2(v[2], v[3]); o.z = pk2(v[4], v[5]); o.w = pk2(v[6], v[7]);
        *(v4u*)(MF + (size_t)row * KY + cp * 8) = o; }
    for (int q = tid; q < 128 * 64; q += 512) { const int rowp = q >> 6, cp = q & 63, part = rowp >> 6, p = rowp & 63, s = cp >> 1, c0 = (cp & 1) * 8, tau = 31 - s;
        const float lr = LR[tau * 64 + p], li = LI[tau * 64 + p]; float v[8];
#pragma unroll
        for (int i = 0; i < 8; ++i) { const float br = BR[p * 16 + c0 + i], bi = BI[p * 16 + c0 + i]; v[i] = part == 0 ? (lr * br - li * bi) : (lr * bi + li * br); }
        v4u o; o.x = pk2(v[0], v[1]); o.y = pk2(v[2], v[3]); o.z = pk2(v[4], v[5]); o.w = pk2(v[6], v[7]);
        *(v4u*)(EE + (size_t)rowp * 512 + cp * 8) = o; }
    __syncthreads();
}

__device__ __forceinline__ void mod_phase(const Args& A, LAS float* L, float* mod, int G, int tid) {
    asm volatile("" : "+v"(tid)); const int lane = tid & 63, wave = tid >> 6;
    LAS float* sc = L; LAS float* red = L + 16384;
    const float* c = (const float*)A.in[I_C];
    for (int idx = tid; idx < 16384; idx += 512) { const int b = idx >> 10, k = idx & 1023; const float v = c[idx]; sc[k * 16 + b] = v / (1.f + expf(-v)); }
    __syncthreads();
    for (int un = G - 1 - (int)blockIdx.x; un < DEPTH * 96; un += G) { const int l = un / 96, col = (un % 96) * 64 + lane;
        const float* W = (const float*)A.in[I_MODW] + (size_t)l * 1024 * 6144 + col;
        float a[16];
#pragma unroll
        for (int i = 0; i < 16; ++i) a[i] = 0.f;
        const int k0 = wave * 128;
#pragma unroll 32
        for (int k = k0; k < k0 + 128; ++k) { const float w = W[(size_t)k * 6144];
            const LAS f32x4* s4 = (const LAS f32x4*)(sc + k * 16);
#pragma unroll
            for (int q = 0; q < 4; ++q) { const f32x4 s = s4[q]; a[4 * q] += s[0] * w; a[4 * q + 1] += s[1] * w; a[4 * q + 2] += s[2] * w; a[4 * q + 3] += s[3] * w; } }
#pragma unroll
        for (int i = 0; i < 16; ++i) red[(wave * 16 + i) * 64 + lane] = a[i];
        __syncthreads();
        for (int o = tid; o < 1024; o += 512) { const int b = o >> 6, cl = o & 63; float s = 0.f;
#pragma unroll
            for (int w = 0; w < 8; ++w) s += red[(w * 16 + b) * 64 + cl];
            const int cg_ = (un % 96) * 64 + cl;
            mod[((size_t)l * 16 + b) * 6144 + cg_] = s + ((const float*)A.in[I_MODB])[l * 6144 + cg_]; }
        __syncthreads();
    }
}

__device__ __forceinline__ void modulate_rows(const float* x, const float* mod_l, int scale_off, bf16* H, int gw, int NGW, int lane) {
    for (int m0 = gw; m0 < M; m0 += 8 * NGW) {
        f32x4 v[8][4];
#pragma unroll
        for (int r = 0; r < 8; ++r) { const int m = (m0 + r * NGW < M) ? m0 + r * NGW : m0; const f32x4* xr = (const f32x4*)(x + (size_t)m * DM) + lane;
#pragma unroll
            for (int j = 0; j < 4; ++j) v[r][j] = xr[64 * j]; }
#pragma unroll
        for (int r = 0; r < 8; ++r) { const int m = m0 + r * NGW; if (m >= M) break; const int b = m >> 11;
            const f32x4* scp = (const f32x4*)(mod_l + (size_t)b * 6144 + scale_off) + lane; v2u* o8 = (v2u*)(H + (size_t)m * DM) + lane;
#pragma unroll
            for (int j = 0; j < 4; ++j) { const f32x4 h = v[r][j] * (scp[64 * j] + 1.0f); v2u w; w.x = pkh2(h[0], h[1]); w.y = pkh2(h[2], h[3]); o8[64 * j] = w; } } }
}
__device__ __forceinline__ void ln_rows_h(const bf16* Hh, float* out, const float* gam, const float* bet, int gw, int NGW, int lane) {
    const f32x4* g4 = (const f32x4*)gam + lane; const f32x4* b4 = (const f32x4*)bet + lane;
    for (int m0 = gw; m0 < M; m0 += 4 * NGW) {
        v2u w[4][4];
#pragma unroll
        for (int r = 0; r < 4; ++r) { const int m = (m0 + r * NGW < M) ? m0 + r * NGW : m0; const v2u* hr = (const v2u*)(Hh + (size_t)m * DM) + lane;
#pragma unroll
            for (int j = 0; j < 4; ++j) w[r][j] = hr[64 * j]; }
#pragma unroll
        for (int r = 0; r < 4; ++r) { const int m = m0 + r * NGW; if (m >= M) break; f32x4* xr = (f32x4*)(out + (size_t)m * DM) + lane;
            f32x4 v[4]; float s = 0.f;
#pragma unroll
            for (int j = 0; j < 4; ++j) { v[j][0] = hlo(w[r][j].x); v[j][1] = hhi(w[r][j].x); v[j][2] = hlo(w[r][j].y); v[j][3] = hhi(w[r][j].y); s += (v[j][0] + v[j][1]) + (v[j][2] + v[j][3]); }
            const float mean = wave_sum(s, lane) * (1.f / DM); float s2 = 0.f;
#pragma unroll
            for (int j = 0; j < 4; ++j) { v[j] = v[j] - mean; s2 += (v[j][0] * v[j][0] + v[j][1] * v[j][1]) + (v[j][2] * v[j][2] + v[j][3] * v[j][3]); }
            const float rstd = 1.f / sqrtf(wave_sum(s2, lane) * (1.f / DM) + LN_EPS);
#pragma unroll
            for (int j = 0; j < 4; ++j) xr[64 * j] = v[j] * rstd * g4[64 * j] + b4[64 * j]; } }
}

__global__ void __launch_bounds__(NWAVES * 64, 2) fwd_mega(Args args) {
    extern __shared__ __attribute__((aligned(16))) unsigned char lds[];
    LAS unsigned char* L = (LAS unsigned char*)lds;
    volatile LAS unsigned* MISC = (volatile LAS unsigned*)(L + MISC_OFF);
    if (args.ph_hi < 0) cg::this_grid().sync();
    const int G = gridDim.x, bx = blockIdx.x, NGW = G * NWAVES;
    const int wave_s = __builtin_amdgcn_readfirstlane((int)threadIdx.x >> 6);
    unsigned char* ws = args.ws;
    for (int u = threadIdx.x; u < (LDS_BYTES - RING_BYTES) / 4; u += NWAVES * 64) ((LAS unsigned*)(L + RING_BYTES))[u] = 0u;
#define PHASE_IDS() int tid = wave_s * 64 + lane_fresh(); asm volatile("" : "+v"(tid)); const int lane = tid & 63, wave = wave_s, gw = bx * NWAVES + wave; (void)lane; (void)gw
    __syncthreads();
    XcdBarrier bar = xcd_barrier_post((unsigned*)(ws + WS_CTL) + 1024, MISC + 8, wave_s);
#define RUN(k) (true)
#define ST(l_, s_) (STATS + (size_t)((l_) * 2 + (s_)) * M * 2)
#define SEAM() do { xcd_barrier(bar, wave_s); } while (0)

    float* CSBW = (float*)(ws + WS_CSBW); float* GP = (float*)(ws + WS_GP); float* GPINV = (float*)(ws + WS_GPINV); float* ONES = (float*)(ws + WS_ONES); bf16* MROWS = (bf16*)(ws + WS_MROWS); float* STATS = (float*)(ws + WS_STATS);
    float* mod = (float*)(ws + WS_MOD); float* cosT = (float*)(ws + WS_COS); float* sinT = (float*)(ws + WS_SIN);
    bf16* H = (bf16*)(ws + WS_H); bf16* Ug = (bf16*)(ws + WS_U); bf16* QKV = (bf16*)(ws + WS_QKV); bf16* CAT = (bf16*)(ws + WS_CAT);
    bf16* YACT = (bf16*)(ws + WS_YACT); bf16* O2 = (bf16*)(ws + WS_O2); float* Sb = (float*)(ws + WS_S); bf16* HDN = (bf16*)(ws + WS_HDN);
    const float* xin = (const float*)args.in[I_X]; float* X = args.out;

    if (RUN(ph)) { PHASE_IDS();
        for (int un = bx; un < DEPTH * NG; un += G) { const int l = un / NG, g = un % NG;
            ssm_tables_unit(args, l, g, (LAS float*)L, (bf16*)(ws + WS_SSM + (size_t)l * SSM_LAYER + SSM_MF) + (size_t)g * 512 * KY,
                            (bf16*)(ws + WS_SSM + (size_t)l * SSM_LAYER + SSM_E) + (size_t)g * 128 * 512, tid); }
        __syncthreads();
        mod_phase(args, (LAS float*)L, mod, G, tid);
        for (int idx = bx * 512 + tid; idx < M * 8; idx += G * 512) { const int row = idx >> 3, i = idx & 7;
            const float freq = powf(500000.0f, -(float)i * 0.125f), ang = (float)((const int*)args.in[I_POS])[row] * freq; float s, c; sincosf(ang, &s, &c);
            cosT[idx] = c; sinT[idx] = s; }
        __syncthreads();
        LAS float* scr = (LAS float*)(L + wave * 16384);
        constexpr int IT_IN = 16 * 16, IT_GLU = 8 * 4, IT_OUT = 16 * 8, IT_G = 16 * 22, IT_D = 44 * 8, IT_L = IT_IN + IT_GLU + IT_OUT + 2 * IT_G + IT_D;
        unsigned* wq = (unsigned*)(ws + WS_CTL) + 64;
        volatile LAS int* qslot = (volatile LAS int*)(L + RING_BYTES + 8192); int par = 0;
        int nxtb = 0; if (tid == 0) nxtb = (int)__hip_atomic_fetch_add(wq, 8u, __ATOMIC_RELAXED, __HIP_MEMORY_SCOPE_AGENT);
        for (;;) { if (tid == 0) qslot[par] = nxtb;
            __syncthreads();
            const int base = qslot[par]; par ^= 1;
            if (base >= DEPTH * IT_L) break;
            if (tid == 0) nxtb = (int)__hip_atomic_fetch_add(wq, 8u, __ATOMIC_RELAXED, __HIP_MEMORY_SCOPE_AGENT);
            const int it = base + wave; if (it >= DEPTH * IT_L) continue;
            const int l = it / IT_L; int r = it % IT_L; unsigned char* wl = ws + WS_W + (size_t)l * W_LAYER;
            if (r < IT_IN) { transpose_item((const float*)args.in[I_WIN] + (size_t)l * 1024 * 2048, 1024, 2048, (bf16*)(wl + W_IN), 1, scr, r, lane, true); continue; } r -= IT_IN;
            if (r < IT_GLU) { transpose_item((const float*)args.in[I_GLUW] + (size_t)l * 512 * 512, 512, 512, (bf16*)(wl + W_GLU), 0, scr, r, lane, false); continue; } r -= IT_GLU;
            if (r < IT_OUT) { transpose_item((const float*)args.in[I_WOUT] + (size_t)l * 1024 * 1024, 1024, 1024, (bf16*)(wl + W_OUT), 0, scr, r, lane, false); continue; } r -= IT_OUT;
            if (r < IT_G) { transpose_item((const float*)args.in[I_WGATE] + (size_t)l * 1024 * DFF, 1024, DFF, (bf16*)(wl + W_GU), 2, scr, r, lane, true); continue; } r -= IT_G;
            if (r < IT_G) { transpose_item((const float*)args.in[I_WUP] + (size_t)l * 1024 * DFF, 1024, DFF, (bf16*)(wl + W_GU), 3, scr, r, lane, true); continue; } r -= IT_G;
            transpose_item((const float*)args.in[I_WDOWN] + (size_t)l * DFF * 1024, DFF, 1024, (bf16*)(wl + W_DN), 0, scr, r, lane, false); }
    }
    SEAM();
    if (RUN(ph)) { PHASE_IDS();
        for (int idx = bx * 512 + tid; idx < 16 * 1024; idx += G * 512) ONES[idx] = 1.0f;
        for (int idx = bx * 512 + tid; idx < DEPTH * 2 * 16 * 1024; idx += G * 512) { const int k = idx & 1023, b = (idx >> 10) & 15, sub = (idx >> 14) & 1, l = idx >> 15;
            float g = 1.f, bb = 0.f, sc, sh; const float* ml = mod + ((size_t)l * 16 + b) * 6144;
            if (sub == 0) { if (l > 0) { g = ((const float*)args.in[I_LN2G])[(l - 1) * 1024 + k]; bb = ((const float*)args.in[I_LN2B])[(l - 1) * 1024 + k]; } sh = ml[k]; sc = ml[1024 + k]; }
            else { g = ((const float*)args.in[I_LN1G])[l * 1024 + k]; bb = ((const float*)args.in[I_LN1B])[l * 1024 + k]; sh = ml[3072 + k]; sc = ml[4096 + k]; }
            const float gpr = g * (1.f + sc), bpr = bb * (1.f + sc) + sh;
            GP[idx] = gpr; GPINV[idx] = 1.0f / gpr;
            bf16* mr = MROWS + ((size_t)(sub * DEPTH + l) * 256) * 1024; mr[(size_t)b * 1024 + k] = (bf16)(pkh2(gpr, 0.f) & 0xffffu); mr[(size_t)(16 + b) * 1024 + k] = (bf16)(pkh2(bpr, 0.f) & 0xffffu); }
    }
    SEAM();
    if (RUN(ph)) { PHASE_IDS();
        { pg8::Gemm g{MROWS, (const bf16*)(ws + WS_W + W_IN), DEPTH * 256, INCOLS, 1024, 1024, 1024, 1, W_LAYER / 2}; pg8::StaticOrder S; S.init(DEPTH * 256, INCOLS, G, bx);
          EpiCsBw E{CSBW, 0}; pg8::gemm_phase<EpiCsBw, pg8::StaticOrder, true>(L, g, S, E, tid); }
        { pg8::Gemm g{MROWS + (size_t)DEPTH * 256 * 1024, (const bf16*)(ws + WS_W + W_GU), DEPTH * 256, 2 * DFF, 1024, 1024, 1024, 1, W_LAYER / 2}; pg8::StaticOrder S; S.init(DEPTH * 256, 2 * DFF, G, G - 1 - bx);
          EpiCsBw E{CSBW, 2048}; pg8::gemm_phase<EpiCsBw, pg8::StaticOrder, true>(L, g, S, E, tid); }
        modulate_rows(xin, mod, 1024, H, gw, NGW, lane);
    }
    SEAM();

    for (int l = 0; l < DEPTH; ++l) {
        unsigned char* wl = ws + WS_W + (size_t)l * W_LAYER;
        const float* mod_l = mod + (size_t)l * 16 * 6144;
        const bf16* MF = (const bf16*)(ws + WS_SSM + (size_t)l * SSM_LAYER + SSM_MF); const bf16* EE = (const bf16*)(ws + WS_SSM + (size_t)l * SSM_LAYER + SSM_E);
        if (RUN(ph)) for (int rep = 0; rep < REP_A; ++rep) { PHASE_IDS(); pg8::Gemm g{H, (const bf16*)(wl + W_IN), M, INCOLS, 1024, 1024, 1024, 1 << 30, 0}; pg8::StaticOrder S; S.init(M, INCOLS, G, bx);
            EpiInProj E{Ug, QKV, cosT, sinT, attn_body::C2, l == 0 ? ST(0, 1) : ST(l - 1, 1), CSBW + (size_t)l * 32 * 7680, l == 0 ? 0 : 1}; pg8::gemm_phase<EpiInProj, pg8::StaticOrder, true>(L, g, S, E, tid); }
        SEAM();
        if (RUN(ph)) for (int rep = 0; rep < REP_B; ++rep) { PHASE_IDS();
            { pg8::Gemm g{Ug, EE, NG * 1024, 256, 512, KY, 512, 4, (size_t)128 * 512}; pg8::StaticOrder S; S.init(NG * 1024, 256, G, bx);
              EpiSsmS E{Sb}; pg8::gemm_phase<EpiSsmS, pg8::StaticOrder>(L, g, S, E, tid); }
            for (int it = bx; it < 128 * 8; it += G) { int bhm = it & 127, sel = (it >> 7) & 1; const int kk = it >> 8;
                if (G == 256) { const int v = it & 255, xx = v & 7, k = v >> 3; bhm = ((2 * xx + (k >> 4)) << 3) | ((k >> 1) & 7); sel = k & 1; }
                const int b = bhm >> 3, hm = bhm & 7, h = hm >> 1;
                const int qb = sel == 0 ? (kk == 0 ? 7 : kk == 1 ? 4 : kk == 2 ? 3 : 0) : (kk == 0 ? 6 : kk == 1 ? 5 : kk == 2 ? 2 : 1);
                attn_body::attn_unit<8>(b, qb, (const attn_body::bf16*)QKV + hm * 64, (const attn_body::bf16*)QKV + 512 + hm * 64,
                                        (const attn_body::bf16*)QKV + 1024 + h * 128, (attn_body::bf16*)O2 + hm * 128, (char*)lds, tid); }
        }
        SEAM();
        if (RUN(ph)) for (int rep = 0; rep < REP_C; ++rep) { PHASE_IDS(); pg8::Gemm g{Ug, MF, NG * 1024, 512, KY, KY, KY, 4, (size_t)512 * KY}; pg8::StaticOrder S; S.init(NG * 1024, 512, G, bx);
            { pg8::Unit uu; int last_pm = -1;
              for (int i = 0; S.next(i, uu); ++i) { if (uu.pm == last_pm) continue; last_pm = uu.pm;
                const int g_ = uu.pm >> 2, chain = tid & 255, half = tid >> 8, p = chain & 63, b_ = (uu.pm & 3) * 4 + (chain >> 6), lg = l * NG + g_;
                const float delta = expf(((const float*)args.in[I_LOGSTEP])[lg]);
                const float lre = fminf(((const float*)args.in[I_ARE])[lg * 64 + p], -1e-4f), lim = ((const float*)args.in[I_AIM])[lg * 64 + p];
                const float mag = expf(lre * delta * 32.f); float sn, cs; sincosf(lim * delta * 32.f, &sn, &cs); const float ar = mag * cs, ai = mag * sn;
                const unsigned rowa = (unsigned)(g_ * 1024 + b_ * 64 + half * 32);
                float sr[32], si[32];
#pragma unroll
                for (int j = 0; j < 32; ++j) { sr[j] = Sb[(rowa + j) * 128u + p]; si[j] = Sb[(rowa + j) * 128u + 64 + p]; }
                LAS float* xch = (LAS float*)L;
                float xr = 0.f, xi = 0.f;
                if (half == 0) {
#pragma unroll
                    for (int j = 0; j < 32; ++j) { bf16* up = Ug + (size_t)(rowa + j) * KY + 512 + p; up[0] = (bf16)f2bf(xr); up[64] = (bf16)f2bf(xi);
                        const float nr = ar * xr - ai * xi + sr[j], ni = ar * xi + ai * xr + si[j]; xr = nr; xi = ni; }
                    xch[chain * 2] = xr; xch[chain * 2 + 1] = xi; }
                __syncthreads();
                if (half == 1) { xr = xch[chain * 2]; xi = xch[chain * 2 + 1];
#pragma unroll
                    for (int j = 0; j < 32; ++j) { bf16* up = Ug + (size_t)(rowa + j) * KY + 512 + p; up[0] = (bf16)f2bf(xr); up[64] = (bf16)f2bf(xi);
                        const float nr = ar * xr - ai * xi + sr[j], ni = ar * xi + ai * xr + si[j]; xr = nr; xi = ni; } }
                __syncthreads(); }
              asm volatile("s_waitcnt vmcnt(0)" ::: "memory"); __syncthreads(); }
            EpiSsmY E{YACT}; pg8::gemm_phase<EpiSsmY, pg8::StaticOrder>(L, g, S, E, tid); }
        SEAM();
        if (RUN(ph)) for (int rep = 0; rep < REP_D; ++rep) { PHASE_IDS();
            { pg8::Gemm g{YACT, (const bf16*)(wl + W_GLU), M, 512, 512, 512, 512, 1 << 30, 0}; pg8::StaticOrder S; S.init(M, 512, G, bx);
              EpiGlu E{YACT, (const float*)args.in[I_GLUB] + l * 512, CAT}; pg8::gemm_phase<EpiGlu, pg8::StaticOrder>(L, g, S, E, tid); }
            const float lam_init = 0.8f - 0.6f * expf(-0.3f * (float)l);
            const float d1 = wave_sum(((const float*)args.in[I_LQ1])[l * 64 + lane] * ((const float*)args.in[I_LK1])[l * 64 + lane], lane);
            const float d2 = wave_sum(((const float*)args.in[I_LQ2])[l * 64 + lane] * ((const float*)args.in[I_LK2])[l * 64 + lane], lane);
            const float lam = expf(d1) - expf(d2) + lam_init;
            const int h = lane >> 4, e0 = (lane & 15) * 8; const float* sw = (const float*)args.in[I_SUBLN] + l * 128 + e0;
            float gn[8];
#pragma unroll
            for (int i = 0; i < 8; ++i) gn[i] = sw[i] * (1.f - lam_init);
            const int cb_base = (G == 256) ? (bx & 7) * 4096 + (bx >> 3) * 8 + wave : gw, cb_str = (G == 256) ? 256 : NGW, cb_lim = (G == 256) ? (bx & 7) * 4096 + 4096 : M;
            for (int m0 = cb_base; m0 < cb_lim; m0 += 8 * cb_str) {
                v4u a[8], b2[8];
#pragma unroll
                for (int r = 0; r < 8; ++r) { const int m = (m0 + r * cb_str < cb_lim) ? m0 + r * cb_str : m0; a[r] = *(const v4u*)(O2 + (size_t)m * 1024 + h * 256 + e0); b2[r] = *(const v4u*)(O2 + (size_t)m * 1024 + h * 256 + 128 + e0); }
#pragma unroll
                for (int r = 0; r < 8; ++r) { const int m = m0 + r * cb_str; if (m >= cb_lim) break;
                    float o[8]; o[0] = bflo(a[r].x) - lam * bflo(b2[r].x); o[1] = bfhi(a[r].x) - lam * bfhi(b2[r].x); o[2] = bflo(a[r].y) - lam * bflo(b2[r].y); o[3] = bfhi(a[r].y) - lam * bfhi(b2[r].y);
                    o[4] = bflo(a[r].z) - lam * bflo(b2[r].z); o[5] = bfhi(a[r].z) - lam * bfhi(b2[r].z); o[6] = bflo(a[r].w) - lam * bflo(b2[r].w); o[7] = bfhi(a[r].w) - lam * bfhi(b2[r].w);
                    float ss = 0.f;
#pragma unroll
                    for (int i = 0; i < 8; ++i) ss += o[i] * o[i];
                    ss += shx(ss, 1, lane); ss += shx(ss, 2, lane); ss += shx(ss, 4, lane); ss += shx(ss, 8, lane);
                    const float rs = 1.f / sqrtf(ss * (1.f / 128.f) + RMS_EPS);
                    v4u w; w.x = pk2(o[0] * rs * gn[0], o[1] * rs * gn[1]); w.y = pk2(o[2] * rs * gn[2], o[3] * rs * gn[3]); w.z = pk2(o[4] * rs * gn[4], o[5] * rs * gn[5]); w.w = pk2(o[6] * rs * gn[6], o[7] * rs * gn[7]);
                    *(v4u*)(CAT + (size_t)m * 1024 + 512 + h * 128 + e0) = w; } }
        }
        SEAM();
        if (RUN(ph)) { PHASE_IDS(); pg8::Gemm g{CAT, (const bf16*)(wl + W_OUT), M, 1024, 1024, 1024, 1024, 1 << 30, 0}; pg8::StaticOrder S; S.init(M, 1024, G, bx);
            EpiResid E{H, GPINV + (size_t)(l * 2) * 16 * 1024, l == 0 ? ST(0, 1) : ST(l - 1, 1), (const float*)args.in[I_LN2G] + (l > 0 ? l - 1 : 0) * 1024, (const float*)args.in[I_LN2B] + (l > 0 ? l - 1 : 0) * 1024,
                       mod_l + 2048, ST(l, 0), GP + (size_t)(l * 2 + 1) * 16 * 1024, l == 0 ? 0 : 1};
            pg8::gemm_phase<EpiResid, pg8::StaticOrder>(L, g, S, E, tid); }
        SEAM();
        if (RUN(ph)) for (int rep = 0; rep < REP_F; ++rep) { PHASE_IDS(); pg8::Gemm g{H, (const bf16*)(wl + W_GU), M, 2 * DFF, 1024, 1024, 1024, 1 << 30, 0}; pg8::StaticOrder S; S.init(M, 2 * DFF, G, bx);
            EpiSwiGlu E{HDN, ST(l, 0), CSBW + (size_t)l * 32 * 7680 + 2048}; pg8::gemm_phase<EpiSwiGlu, pg8::StaticOrder, true>(L, g, S, E, tid); }
        SEAM();
        if (RUN(ph)) { PHASE_IDS(); pg8::Gemm g{HDN, (const bf16*)(wl + W_DN), M, 1024, DFF, DFF, DFF, 1 << 30, 0}; pg8::StaticOrder S; S.init(M, 1024, G, bx);
            EpiResid E{H, GPINV + (size_t)(l * 2 + 1) * 16 * 1024, ST(l, 0), (const float*)args.in[I_LN1G] + l * 1024, (const float*)args.in[I_LN1B] + l * 1024,
                       mod_l + 5120, ST(l, 1), (l + 1 < DEPTH) ? GP + (size_t)((l + 1) * 2) * 16 * 1024 : ONES, 1};
            pg8::gemm_phase<EpiResid, pg8::StaticOrder>(L, g, S, E, tid); }
        SEAM();
    }
    if (RUN(ph)) { PHASE_IDS(); ln_rows_h(H, X, (const float*)args.in[I_LN2G] + 3 * 1024, (const float*)args.in[I_LN2B] + 3 * 1024, gw, NGW, lane); }
#undef RUN
#undef SEAM
#undef ST
}

#ifndef N_LAUNCHES
#define N_LAUNCHES 1
#endif
constexpr int N_PHASES = 3 + DEPTH * 7 + 1;

extern "C" void kernel_launch(void* const* d_in, const int* in_sizes, int n_in, void* d_out, int out_size, void* d_ws, size_t ws_size, hipStream_t stream) {
    static int grid = 0;
    if (grid == 0) {
        if (n_in != 29 || out_size != M * DM || ws_size < WS_END) { fprintf(stderr, "kernel_launch: unexpected problem (n_in %d out %d ws %zu)\n", n_in, out_size, ws_size); grid = -1; return; }
        int dev = 0, cus = 0, per_cu = 0;
        hipGetDevice(&dev); hipDeviceGetAttribute(&cus, hipDeviceAttributeMultiprocessorCount, dev);
        if (hipFuncSetAttribute((const void*)fwd_mega, hipFuncAttributeMaxDynamicSharedMemorySize, LDS_BYTES) != hipSuccess) { fprintf(stderr, "kernel_launch: hipFuncSetAttribute failed\n"); grid = -1; return; }
        if (hipOccupancyMaxActiveBlocksPerMultiprocessor(&per_cu, (const void*)fwd_mega, NWAVES * 64, LDS_BYTES) != hipSuccess || per_cu < 1) { fprintf(stderr, "kernel_launch: occupancy query says %d\n", per_cu); per_cu = 1; }
        (void)hipGetLastError();
        grid = cus;
    }
    if (grid < 0) return;
    (void)hipMemsetAsync((char*)d_ws + WS_CTL, 0, CTL_ZERO_BYTES, stream);
    Args a{};
    for (int i = 0; i < 29; ++i) a.in[i] = d_in[i];
    a.out = (float*)d_out; a.ws = (unsigned char*)d_ws;
    {
        a.ph_lo = 0; a.ph_hi = N_PHASES;
        void* kargs[] = {&a};
        hipError_t e = hipLaunchCooperativeKernel((const void*)fwd_mega, dim3(grid), dim3(NWAVES * 64), kargs, LDS_BYTES, stream);
        if (e != hipSuccess) fprintf(stderr, "cooperative launch failed: %s (grid %d)\n", hipGetErrorString(e), grid);
    }
}
```
